# Optimizing an MI355X kernel written in HIP

```python
import math
import jax, jax.numpy as jnp
from jax import lax
import numpy as np

D_MODEL = 1024
BATCH = 16
SEQ = 4096
DEPTH = 4
DEC_BATCH = 16
DEC_SEQ = 2048
PAST_LEN = 128

D_MIX = D_MODEL
D_ATTN = D_MIX // 2
D_HY = D_MIX - D_ATTN
HEAD_DIM = 64
N_Q_HEADS = D_ATTN // HEAD_DIM
N_KV_HEADS = 2
GQA_GROUP = N_Q_HEADS // N_KV_HEADS
KV_WIDTH = N_KV_HEADS * HEAD_DIM
ROT_DIM = HEAD_DIM // 4
ROPE_THETA = 500000.0
WINDOW = 128
BLOCK = 128
HY_ORDER = 2
SHORT_K = 3
FILTER_EMB = 33
FILTER_HID = 64
DECAY_TARGET = 1e-2
FAST_DECAY_PCT = 0.3
SLOW_DECAY_PCT = 1.5
D_FF = 2816
N_IN = D_ATTN + 2 * KV_WIDTH + (HY_ORDER + 1) * D_HY
N_MOD = 9
ALPHA = float((2 * DEPTH) ** 0.25)
BETA = float((8 * DEPTH) ** -0.25)
LN_EPS = 1e-5
RMS_EPS = 1e-6

kernel_name = "hymba_attn_hyena_macaron_deepnorm_encoder"


def _layer_norm(x, g, b):
    xf = x.astype(jnp.float32)
    mu = xf.mean(-1, keepdims=True)
    var = jnp.square(xf - mu).mean(-1, keepdims=True)
    return ((xf - mu) * lax.rsqrt(var + LN_EPS) * g.astype(jnp.float32) + b.astype(jnp.float32)).astype(x.dtype)


def _rms_norm(x, g):
    xf = x.astype(jnp.float32)
    ms = jnp.square(xf).mean(-1, keepdims=True)
    return (xf * lax.rsqrt(ms + RMS_EPS) * g.astype(jnp.float32)).astype(x.dtype)


def _swiglu(h, wi, wo):
    g, u = jnp.split(h @ wi, 2, axis=-1)
    return (jax.nn.silu(g) * u) @ wo


def _partial_rope(x, L):
    inv = ROPE_THETA ** (-jnp.arange(0, ROT_DIM, 2, dtype=jnp.float32) / ROT_DIM)
    ang = jnp.arange(L, dtype=jnp.float32)[:, None] * inv[None]
    cos = jnp.cos(ang)[None, :, None, :]
    sin = jnp.sin(ang)[None, :, None, :]
    xr = x[..., :ROT_DIM].astype(jnp.float32)
    x1, x2 = xr[..., : ROT_DIM // 2], xr[..., ROT_DIM // 2:]
    rot = jnp.concatenate([x1 * cos - x2 * sin, x2 * cos + x1 * sin], axis=-1)
    return jnp.concatenate([rot.astype(x.dtype), x[..., ROT_DIM:]], axis=-1)


def _window_attention(q, k, v, sink):
    B, L = q.shape[0], q.shape[1]
    nb = L // BLOCK
    pad = ((0, 0), (BLOCK, BLOCK), (0, 0), (0, 0))

    def bands(t):
        tb = jnp.pad(t, pad).reshape(B, nb + 2, BLOCK, N_KV_HEADS, HEAD_DIM)
        return jnp.concatenate([tb[:, :-2], tb[:, 1:-1], tb[:, 2:]], axis=2)

    kb, vb = bands(k), bands(v)
    qb = q.reshape(B, nb, BLOCK, N_KV_HEADS, GQA_GROUP, HEAD_DIM)
    s = jnp.einsum('bnqkgd,bnskd->bnkgqs', qb, kb, preferred_element_type=jnp.float32) * (HEAD_DIM ** -0.5)
    qpos = jnp.arange(nb)[:, None] * BLOCK + jnp.arange(BLOCK)[None]
    kpos = (jnp.arange(nb)[:, None] - 1) * BLOCK + jnp.arange(3 * BLOCK)[None]
    valid = ((jnp.abs(qpos[:, :, None] - kpos[:, None, :]) <= WINDOW)
             & (kpos[:, None, :] >= 0) & (kpos[:, None, :] < L))
    s = jnp.where(valid[None, :, None, None], s, -jnp.inf)
    sink_f = sink.astype(jnp.float32).reshape(N_KV_HEADS, GQA_GROUP)[None, None, :, :, None, None]
    m = jnp.maximum(s.max(-1, keepdims=True), sink_f)
    p = jnp.exp(s - m)
    p = p / (p.sum(-1, keepdims=True) + jnp.exp(sink_f - m))
    o = jnp.einsum('bnkgqs,bnskd->bnqkgd', p.astype(v.dtype), vb)
    return o.reshape(B, L, N_Q_HEADS * HEAD_DIM)


def _short_conv(u, w, b):
    up = jnp.pad(u, ((0, 0), (1, 1), (0, 0)))
    return up[:, :-2] * w[0] + up[:, 1:-1] * w[1] + up[:, 2:] * w[2] + b


def _hyena_filters(L, w1, b1, w2, b2, w3, b3, w4, freq, decay):
    f32 = jnp.float32
    t = jnp.linspace(0.0, 1.0, L, dtype=f32)[:, None]
    n_bands = (FILTER_EMB - 1) // 2
    w = 2.0 * math.pi * jnp.arange(L, dtype=f32)[:, None] / L
    fb = jnp.linspace(1e-4, n_bands - 1, n_bands, dtype=f32)[None]
    z = jnp.concatenate([t, jnp.cos(fb * w), -jnp.sin(fb * w)], axis=-1)
    fr = freq.astype(f32)
    h = jnp.sin(fr * (z @ w1.astype(f32) + b1.astype(f32)))
    h = jnp.sin(fr * (h @ w2.astype(f32) + b2.astype(f32)))
    h = jnp.sin(fr * (h @ w3.astype(f32) + b3.astype(f32)))
    h = (h @ w4.astype(f32)).reshape(L, 2, D_HY)
    window = jnp.exp(-t[:, :, None] * jnp.abs(decay.astype(f32))[None])
    return h * window


def _bidir_long_conv(u, filt, bias):
    L = u.shape[1]
    hf, hb = filt[:, 0], filt[:, 1]
    kern = jnp.concatenate([hf[:1] + hb[:1], hf[1:], jnp.zeros((1, D_HY), jnp.float32), hb[:0:-1]], axis=0)
    uf = u.astype(jnp.float32)
    U = jnp.fft.rfft(uf, n=2 * L, axis=1)
    K = jnp.fft.rfft(kern, n=2 * L, axis=0)
    y = jnp.fft.irfft(U * K[None], n=2 * L, axis=1)[:, :L]
    return (y + uf * bias.astype(jnp.float32)).astype(u.dtype)


def _modulate(x, shift, scale):
    return x * (1.0 + scale[:, None, :]) + shift[:, None, :]


def _trunk(x, c, ada_w, ada_b, ffn1_wi, ffn1_wo, ffn2_wi, ffn2_wo, ln_g, ln_b, w_in, w_out, sink,
           grp_norm_g, hy_conv_w, hy_conv_b, hy_w1, hy_b1, hy_w2, hy_b2, hy_w3, hy_b3, hy_w4,
           hy_freq, hy_decay, hy_bias):
    B, L = x.shape[0], x.shape[1]
    for l in range(DEPTH):
        mod = (jax.nn.silu(c) @ ada_w[l] + ada_b[l]).reshape(B, N_MOD, D_MODEL)
        h = _modulate(x, mod[:, 0], mod[:, 1])
        f = _swiglu(h, ffn1_wi[l], ffn1_wo[l])
        x = _layer_norm(ALPHA * x + 0.5 * (1.0 + mod[:, 2][:, None, :]) * f, ln_g[l, 0], ln_b[l, 0])
        h = _modulate(x, mod[:, 3], mod[:, 4])
        z = h @ w_in[l]
        q, k, v, hz = jnp.split(z, [D_ATTN, D_ATTN + KV_WIDTH, D_ATTN + 2 * KV_WIDTH], axis=-1)
        q = _partial_rope(q.reshape(B, L, N_Q_HEADS, HEAD_DIM), L)
        k = _partial_rope(k.reshape(B, L, N_KV_HEADS, HEAD_DIM), L)
        v = v.reshape(B, L, N_KV_HEADS, HEAD_DIM)
        o_attn = _window_attention(q, k, v, sink[l])
        hz = _short_conv(hz, hy_conv_w[l], hy_conv_b[l])
        x0, x1, hv = jnp.split(hz, 3, axis=-1)
        filt = _hyena_filters(L, hy_w1[l], hy_b1[l], hy_w2[l], hy_b2[l], hy_w3[l], hy_b3[l], hy_w4[l],
                              hy_freq[l], hy_decay[l])
        o_hy = _bidir_long_conv(hv * x1, filt, hy_bias[l]) * x0
        o = jnp.concatenate([_rms_norm(o_attn, grp_norm_g[l, :D_ATTN]),
                             _rms_norm(o_hy, grp_norm_g[l, D_ATTN:])], axis=-1) @ w_out[l]
        x = _layer_norm(ALPHA * x + (1.0 + mod[:, 5][:, None, :]) * o, ln_g[l, 1], ln_b[l, 1])
        h = _modulate(x, mod[:, 6], mod[:, 7])
        f = _swiglu(h, ffn2_wi[l], ffn2_wo[l])
        x = _layer_norm(ALPHA * x + 0.5 * (1.0 + mod[:, 8][:, None, :]) * f, ln_g[l, 2], ln_b[l, 2])
    return x


def setup_inputs(seed: int = 0) -> dict:
    key = jax.random.key(seed)
    ks = jax.random.split(key, 32)
    f32 = jnp.float32
    n = lambda i, shape, s: jax.random.normal(ks[i], shape, f32) * s
    base_decay = jnp.abs(jnp.linspace(math.log(DECAY_TARGET) / FAST_DECAY_PCT,
                                      math.log(DECAY_TARGET) / SLOW_DECAY_PCT, D_HY, dtype=f32))
    return {
        "x_prompt": n(0, (BATCH, SEQ, D_MODEL), 1.0),
        "x_sample": n(1, (DEC_BATCH, DEC_SEQ, D_MODEL), 1.0),
        "c_prompt": n(2, (BATCH, D_MODEL), 1.0),
        "c_sample": n(3, (DEC_BATCH, D_MODEL), 1.0),
        "ada_w": n(4, (DEPTH, D_MODEL, N_MOD * D_MODEL), 0.5 * D_MODEL ** -0.5),
        "ada_b": n(5, (DEPTH, N_MOD * D_MODEL), 0.01),
        "ffn1_wi": n(6, (DEPTH, D_MODEL, 2 * D_FF), D_MODEL ** -0.5),
        "ffn1_wo": n(7, (DEPTH, D_FF, D_MODEL), BETA * D_FF ** -0.5),
        "ffn2_wi": n(8, (DEPTH, D_MODEL, 2 * D_FF), D_MODEL ** -0.5),
        "ffn2_wo": n(9, (DEPTH, D_FF, D_MODEL), BETA * D_FF ** -0.5),
        "ln_g": 1.0 + n(10, (DEPTH, 3, D_MODEL), 0.02),
        "ln_b": n(11, (DEPTH, 3, D_MODEL), 0.02),
        "w_in": n(12, (DEPTH, D_MODEL, N_IN), D_MODEL ** -0.5),
        "w_out": n(13, (DEPTH, D_MIX, D_MODEL), BETA * D_MIX ** -0.5),
        "sink": n(14, (DEPTH, N_Q_HEADS), 1.0),
        "grp_norm_g": 1.0 + n(15, (DEPTH, D_MIX), 0.02),
        "hy_conv_w": n(16, (DEPTH, SHORT_K, (HY_ORDER + 1) * D_HY), SHORT_K ** -0.5),
        "hy_conv_b": n(17, (DEPTH, (HY_ORDER + 1) * D_HY), 0.02),
        "hy_w1": n(18, (DEPTH, FILTER_EMB, FILTER_HID), FILTER_EMB ** -0.5),
        "hy_b1": n(19, (DEPTH, FILTER_HID), 0.02),
        "hy_w2": n(20, (DEPTH, FILTER_HID, FILTER_HID), FILTER_HID ** -0.5),
        "hy_b2": n(21, (DEPTH, FILTER_HID), 0.02),
        "hy_w3": n(22, (DEPTH, FILTER_HID, FILTER_HID), FILTER_HID ** -0.5),
        "hy_b3": n(23, (DEPTH, FILTER_HID), 0.02),
        "hy_w4": n(24, (DEPTH, FILTER_HID, 2 * D_HY), FILTER_HID ** -0.5),
        "hy_freq": 1.0 + n(25, (DEPTH, FILTER_HID), 0.05),
        "hy_decay": base_decay[None, None, :] * (1.0 + n(26, (DEPTH, 2, D_HY), 0.05)),
        "hy_bias": n(27, (DEPTH, D_HY), 0.5),
    }


def reference(x_prompt, x_sample, c_prompt, c_sample, ada_w, ada_b, ffn1_wi, ffn1_wo, ffn2_wi, ffn2_wo,
              ln_g, ln_b, w_in, w_out, sink, grp_norm_g, hy_conv_w, hy_conv_b, hy_w1, hy_b1, hy_w2, hy_b2,
              hy_w3, hy_b3, hy_w4, hy_freq, hy_decay, hy_bias):
    y_prompt = _trunk(x_prompt, c_prompt, ada_w, ada_b, ffn1_wi, ffn1_wo, ffn2_wi, ffn2_wo, ln_g, ln_b,
                      w_in, w_out, sink, grp_norm_g, hy_conv_w, hy_conv_b, hy_w1, hy_b1, hy_w2, hy_b2,
                      hy_w3, hy_b3, hy_w4, hy_freq, hy_decay, hy_bias)
    y_sample = _trunk(x_sample, c_sample, ada_w, ada_b, ffn1_wi, ffn1_wo, ffn2_wi, ffn2_wo, ln_g, ln_b,
                      w_in, w_out, sink, grp_norm_g, hy_conv_w, hy_conv_b, hy_w1, hy_b1, hy_w2, hy_b2,
                      hy_w3, hy_b3, hy_w4, hy_freq, hy_decay, hy_bias)
    return (y_prompt, y_sample)
```

```cpp
#include <hip/hip_runtime.h>
#include <hip/hip_cooperative_groups.h>
#include <cstdio>
#include <cstdint>
namespace cg = cooperative_groups;
__device__ __forceinline__ int ltid() { int t = threadIdx.x; asm volatile("" : "+v"(t)); return t; }
template <class T> __device__ __forceinline__ T* lptr(T* q) { unsigned long long v = (unsigned long long)q; asm volatile("" : "+s"(v)); return (T*)v; }
namespace pg8 {
#define PG8_LAS __attribute__((address_space(3)))
typedef unsigned short bf16_t;
typedef short bf16x8 __attribute__((ext_vector_type(8)));
typedef float f32x4 __attribute__((ext_vector_type(4)));
typedef unsigned u32x4 __attribute__((ext_vector_type(4)));
constexpr int BM = 256, BK = 64, HALF = 128, HTB = HALF * BK * 2  , STAGE_BYTES = 8 * HTB, NXCD = 8, WGM = 8;

__host__ __device__ __forceinline__ int lds_byte(int r, int c) { const int st = (r >> 4) * 2 + (c >> 5), rr = r & 15, cc = c & 31, ob = rr * 64 + cc * 2; return st * 1024 + (ob ^ (((ob >> 9) & 1) << 5)); }
__host__ __device__ __forceinline__ void stage_rc(int b, int& R, int& C) { const int st = b / 1024, sb = b % 1024, swz = sb ^ (((sb >> 9) & 1) << 5); R = (st >> 1) * 16 + swz / 64; C = (st & 1) * 32 + (swz % 64) / 2; }
__host__ __device__ __forceinline__ int perm32(int rho) { const int n = rho >> 4, i = rho & 15; return 8 * (i >> 2) + 4 * n + (i & 3); }

struct Unit { int pm, pn; };
struct Gemm { const bf16_t* A; const bf16_t* Bt; int M, N, K; };
struct StaticOrder {
    int nM, nN, nwg, G, c;
    __host__ __device__ void init(int M, int N, int G_, int c_) { nM = M / BM; nN = N / BM; nwg = nM * nN; G = G_; c = c_; }
    __host__ __device__ bool next(int i, Unit& u) const {
        const long L = (long)i * G + c; if (L >= nwg) return false;
        int wgid = (int)L; { const int q = nwg / NXCD, r = nwg % NXCD, xcd = wgid % NXCD, off = wgid / NXCD; wgid = (xcd < r ? xcd * (q + 1) : r * (q + 1) + (xcd - r) * q) + off; }
        const int nig = WGM * nN, gid = wgid / nig, fm = gid * WGM, gsz = (nM - fm) < WGM ? (nM - fm) : WGM;
        u.pm = fm + ((wgid % nig) % gsz); u.pn = (wgid % nig) / gsz; return true;
    }
    __device__ __forceinline__ void a_ready(const Unit&) const {}
    __device__ __forceinline__ void done(const Unit&) const {}
};
__device__ __forceinline__ unsigned cvt_pk_bf16(float lo, float hi) { unsigned r; asm volatile("v_cvt_pk_bf16_f32 %0, %1, %2" : "=v"(r) : "v"(lo), "v"(hi)); return r; }
struct EpiSwiGLU {
    static constexpr bool PERM = true, AFTER_DRAIN = false;
    bf16_t* O;
    __device__ __forceinline__ void operator()(const f32x4 (&acc)[2][2][4][2], const Unit& u, int wr, int wc, int fr, int fq) const {
        const int row0 = u.pm * BM + wr * 64 + fr, col0 = u.pn * 128 + wc * 32 + 8 * fq;
#pragma unroll
        for (int ai = 0; ai < 2; ++ai)
#pragma unroll
            for (int m = 0; m < 4; ++m) {
                bf16_t* p = O + (size_t)(row0 + ai * HALF + m * 16) * 2816 + col0;
                float v[8];
#pragma unroll
                for (int n = 0; n < 2; ++n)
#pragma unroll
                    for (int j = 0; j < 4; ++j) { const float g = acc[ai][0][m][n][j], uu = acc[ai][1][m][n][j]; v[n * 4 + j] = g * uu * __builtin_amdgcn_rcpf(1.0f + __expf(-g)); }
                u32x4 pk; pk[0] = cvt_pk_bf16(v[0], v[1]); pk[1] = cvt_pk_bf16(v[2], v[3]); pk[2] = cvt_pk_bf16(v[4], v[5]); pk[3] = cvt_pk_bf16(v[6], v[7]);
                *(u32x4*)p = pk;
            }
    }
};
struct EpiResid {
    static constexpr bool PERM = false, AFTER_DRAIN = false;
    float* X; const float* gate; float coef;
    __device__ __forceinline__ void operator()(const f32x4 (&acc)[2][2][4][2], const Unit& u, int wr, int wc, int fr, int fq) const {
        const int bidx = u.pm < 256 ? (u.pm >> 4) : 16 + ((u.pm - 256) >> 3);
        const int row0 = u.pm * BM + wr * 64 + fr, col0 = u.pn * BM + wc * 32 + 4 * fq;
        const float* gp = gate + (size_t)bidx * 9216 + col0;
        f32x4 gv[2][2];
#pragma unroll
        for (int bj = 0; bj < 2; ++bj)
#pragma unroll
            for (int n = 0; n < 2; ++n) { const f32x4 t = *(const f32x4*)(gp + bj * HALF + n * 16); gv[bj][n] = (t + 1.0f) * coef; }
#pragma unroll
        for (int ai = 0; ai < 2; ++ai)
#pragma unroll
            for (int m = 0; m < 4; ++m) { float* rowp = X + (size_t)(row0 + ai * HALF + m * 16) * 1024 + col0;
#pragma unroll
                for (int bj = 0; bj < 2; ++bj)
#pragma unroll
                    for (int n = 0; n < 2; ++n) { const f32x4 xv = *(const f32x4*)(rowp + bj * HALF + n * 16); *(f32x4*)(rowp + bj * HALF + n * 16) = xv * 1.681792830507429f + gv[bj][n] * acc[ai][bj][m][n]; } }
    }
};
struct EpiStore {
    static constexpr bool PERM = true, AFTER_DRAIN = false;
    bf16_t* O; size_t ldc;
    __device__ __forceinline__ void operator()(const f32x4 (&acc)[2][2][4][2], const Unit& u, int wr, int wc, int fr, int fq) const {
        const int row0 = u.pm * BM + wr * 64 + fr, col0 = u.pn * BM + wc * 32 + 8 * fq;
#pragma unroll
        for (int ai = 0; ai < 2; ++ai)
#pragma unroll
            for (int m = 0; m < 4; ++m) { bf16_t* p = O + (size_t)(row0 + ai * HALF + m * 16) * ldc + col0;
#pragma unroll
                for (int bj = 0; bj < 2; ++bj) { const f32x4 v0 = acc[ai][bj][m][0], v1 = acc[ai][bj][m][1];
                    u32x4 pk; pk[0] = cvt_pk_bf16(v0[0], v0[1]); pk[1] = cvt_pk_bf16(v0[2], v0[3]); pk[2] = cvt_pk_bf16(v1[0], v1[1]); pk[3] = cvt_pk_bf16(v1[2], v1[3]);
                    *(u32x4*)(p + bj * HALF) = pk; } }
    }
};

struct EpiAny {
    static constexpr bool AFTER_DRAIN = false;
    int mode; bool perm; bf16_t* O; size_t ldc; float* X; const float* gate; float coef;
    __device__ __forceinline__ void operator()(const f32x4 (&acc)[2][2][4][2], const Unit& u, int wr, int wc, int fr, int fq) const {
        if (mode == 0) { EpiSwiGLU e{O}; e(acc, u, wr, wc, fr, fq); }
        else if (mode == 1) { EpiResid e{X, gate, coef}; e(acc, u, wr, wc, fr, fq); }
        else { EpiStore e{O, ldc}; e(acc, u, wr, wc, fr, fq); }
    }
};
template <class Epi, class Sched, bool STAMP = false>
__device__ __forceinline__ void gemm_phase(PG8_LAS unsigned char* lds, const Gemm g, const Sched& S, const Epi& E, unsigned long long* stamps) {
    const int tid = ltid(), wid = __builtin_amdgcn_readfirstlane(tid >> 6), lane = tid & 63, wr = wid >> 2, wc = wid & 3, fr = lane & 15, fq = lane >> 4;
    const int K = g.K, nt = K / BK;
    int ts_lo = 0, ts_hi = 0, nts = 0; const unsigned long long rt_entry = STAMP ? (unsigned long long)wall_clock64() : 0ull;
#define PG8_STAMP() do { if (STAMP && wid == 0 && nts < 64) { const unsigned long long _c = (unsigned long long)clock64(); \
        ts_lo = (lane == nts) ? (int)(unsigned)_c : ts_lo; ts_hi = (lane == nts) ? (int)(unsigned)(_c >> 32) : ts_hi; ++nts; } } while (0)
    PG8_STAMP();
    unsigned voffA[2], voffB[2];
#pragma unroll
    for (int i = 0; i < 2; ++i) { int R, C; stage_rc(tid * 16 + i * 8192, R, C); const int Rb = E.perm ? ((R & ~31) + perm32(R & 31)) : R;
        voffA[i] = (unsigned)(R * K + C) * 2u; voffB[i] = (unsigned)(Rb * K + C) * 2u; }
    const size_t kstep = (size_t)(BK * 2);
    const size_t hstep = (size_t)HALF * K * 2;
    const size_t tstep = 2 * hstep;
    const unsigned ldsw = (unsigned)wid * 1024u;
    const int aoff = lds_byte(wr * 64 + fr, fq * 8), boff = lds_byte(wc * 32 + fr, fq * 8);
#define PG8_SA(b, h) (((b) * 2 + (h)) * HTB)
#define PG8_SB(b, h) ((4 + (b) * 2 + (h)) * HTB)
#define PG8_STAGE(bufoff, gbase, voff) do { _Pragma("unroll") for (int _i = 0; _i < 2; ++_i) \
        __builtin_amdgcn_global_load_lds((const unsigned*)((const char*)(gbase) + (voff)[_i]), (PG8_LAS unsigned*)(lds + (bufoff) + ldsw + _i * 8192), 16, 0, 0); } while (0)
#define PG8_LDA(dst, b, h) do { _Pragma("unroll") for (int m = 0; m < 4; ++m) _Pragma("unroll") for (int k = 0; k < 2; ++k) dst[m][k] = *(const PG8_LAS bf16x8*)(lds + PG8_SA(b, h) + aoff + m * 2048 + k * 1024); } while (0)
#define PG8_LDB(dst, b, h) do { _Pragma("unroll") for (int n = 0; n < 2; ++n) _Pragma("unroll") for (int k = 0; k < 2; ++k) dst[n][k] = *(const PG8_LAS bf16x8*)(lds + PG8_SB(b, h) + boff + n * 2048 + k * 1024); } while (0)
#define PG8_MMA(ai, bj, At, Bt) do { __builtin_amdgcn_s_setprio(1); _Pragma("unroll") for (int m = 0; m < 4; ++m) _Pragma("unroll") for (int n = 0; n < 2; ++n) _Pragma("unroll") for (int k = 0; k < 2; ++k) \
        acc[ai][bj][m][n] = __builtin_amdgcn_mfma_f32_16x16x32_bf16(Bt[n][k], At[m][k], acc[ai][bj][m][n], 0, 0, 0); __builtin_amdgcn_s_setprio(0); } while (0)
#define PG8_WAIT_V(n) asm volatile("s_waitcnt vmcnt(" #n ")" ::: "memory")
#define PG8_WAIT_L(n) asm volatile("s_waitcnt lgkmcnt(" #n ")" ::: "memory")
#define PG8_BAR __builtin_amdgcn_s_barrier()
#define PG8_SCHED __builtin_amdgcn_sched_barrier(0)
    Unit cur, nxt; int ui = 0;
    if (!S.next(0, cur)) return;
    f32x4 acc[2][2][4][2];
#pragma unroll
    for (int a = 0; a < 2; ++a)
#pragma unroll
        for (int b = 0; b < 2; ++b)
#pragma unroll
            for (int m = 0; m < 4; ++m)
#pragma unroll
                for (int n = 0; n < 2; ++n) acc[a][b][m][n] = (f32x4){0.f, 0.f, 0.f, 0.f};
    bf16x8 At[4][2], B0[2][2], B1[2][2];
    const char* cA = (const char*)g.A + (size_t)cur.pm * tstep; const char* cB = (const char*)g.Bt + (size_t)cur.pn * tstep;
    S.a_ready(cur);
    PG8_STAGE(PG8_SB(0, 0), cB, voffB); PG8_STAGE(PG8_SA(0, 0), cA, voffA); PG8_STAGE(PG8_SB(0, 1), cB + hstep, voffB); PG8_STAGE(PG8_SA(0, 1), cA + hstep, voffA);
    if (wr == 1) PG8_BAR;
    PG8_WAIT_V(4); PG8_BAR;
    PG8_STAGE(PG8_SB(1, 0), cB + kstep, voffB); PG8_STAGE(PG8_SA(1, 0), cA + kstep, voffA); PG8_STAGE(PG8_SB(1, 1), cB + hstep + kstep, voffB);
    PG8_WAIT_V(6); PG8_BAR;
    PG8_STAMP();
    for (;;) {
        const bool has_next = S.next(ui + 1, nxt);
        const char* nA = has_next ? (const char*)g.A + (size_t)nxt.pm * tstep : cA; const char* nB = has_next ? (const char*)g.Bt + (size_t)nxt.pn * tstep : cB;
        for (int t = 0; t < nt; t += 2) {
            const bool last = (t == nt - 2);
            const char* a1 = cA + (size_t)(t + 1) * kstep;
            const char* a2 = last ? nA : cA + (size_t)(t + 2) * kstep; const char* b2 = last ? nB : cB + (size_t)(t + 2) * kstep;
            const char* a3 = a2 + kstep; const char* b3 = b2 + kstep;
            if (last && has_next) S.a_ready(nxt);
            PG8_LDB(B0, 0, 0); PG8_SCHED; PG8_LDA(At, 0, 0); PG8_STAGE(PG8_SA(1, 1), a1 + hstep, voffA);
            PG8_WAIT_L(8); PG8_BAR; PG8_WAIT_L(0); PG8_MMA(0, 0, At, B0); PG8_BAR; PG8_SCHED;
            PG8_LDB(B1, 0, 1); PG8_STAGE(PG8_SB(0, 0), b2, voffB);
            PG8_BAR; PG8_WAIT_L(0); PG8_MMA(0, 1, At, B1); PG8_BAR;
            PG8_LDA(At, 0, 1); PG8_STAGE(PG8_SA(0, 0), a2, voffA);
            PG8_BAR; PG8_WAIT_L(0); PG8_MMA(1, 0, At, B0); PG8_BAR; PG8_SCHED;
            PG8_STAGE(PG8_SB(0, 1), b2 + hstep, voffB);
            PG8_WAIT_V(6); PG8_BAR; PG8_MMA(1, 1, At, B1); PG8_BAR;
            PG8_LDB(B0, 1, 0); PG8_SCHED; PG8_LDA(At, 1, 0); PG8_STAGE(PG8_SA(0, 1), a2 + hstep, voffA);
            PG8_WAIT_L(8); PG8_BAR; PG8_WAIT_L(0); PG8_MMA(0, 0, At, B0); PG8_BAR; PG8_SCHED;
            PG8_LDB(B1, 1, 1); PG8_STAGE(PG8_SB(1, 0), b3, voffB);
            PG8_BAR; PG8_WAIT_L(0); PG8_MMA(0, 1, At, B1); PG8_BAR;
            PG8_LDA(At, 1, 1); PG8_STAGE(PG8_SA(1, 0), a3, voffA);
            PG8_BAR; PG8_WAIT_L(0); PG8_MMA(1, 0, At, B0); PG8_BAR; PG8_SCHED;
            PG8_STAGE(PG8_SB(1, 1), b3 + hstep, voffB);
            PG8_WAIT_V(6); PG8_BAR; PG8_MMA(1, 1, At, B1); PG8_BAR;
        }
        PG8_STAMP();
        if constexpr (!Epi::AFTER_DRAIN) { E(acc, cur, wr, wc, fr, fq); S.done(cur); }
        PG8_STAMP();
        if (!has_next) break;
#pragma unroll
        for (int a = 0; a < 2; ++a)
#pragma unroll
            for (int b = 0; b < 2; ++b)
#pragma unroll
                for (int m = 0; m < 4; ++m)
#pragma unroll
                    for (int n = 0; n < 2; ++n) acc[a][b][m][n] = (f32x4){0.f, 0.f, 0.f, 0.f};
        cur = nxt; cA = nA; cB = nB; ++ui;
    }
    PG8_WAIT_V(0);
    if (wr == 0) PG8_BAR;
    PG8_BAR;
    if constexpr (Epi::AFTER_DRAIN) { E.fused(acc, cur, wr, wc, fr, fq, lds, wid, lane); S.done(cur); }
    PG8_STAMP();
    if (STAMP && wid == 0) { stamps[lane] = lane < nts ? (((unsigned long long)(unsigned)ts_hi << 32) | (unsigned)ts_lo) : 0ull;
        if (lane == 62) stamps[62] = rt_entry; if (lane == 63) stamps[63] = (unsigned long long)wall_clock64(); }
#undef PG8_STAMP
#undef PG8_SA
#undef PG8_SB
#undef PG8_STAGE
#undef PG8_LDA
#undef PG8_LDB
#undef PG8_MMA
#undef PG8_WAIT_V
#undef PG8_WAIT_L
#undef PG8_BAR
#undef PG8_SCHED
}
}

typedef unsigned short bf16_t;
typedef short bf16x8 __attribute__((ext_vector_type(8)));
typedef float f32x4 __attribute__((ext_vector_type(4)));
typedef float f32x16 __attribute__((ext_vector_type(16)));
typedef unsigned u32x4 __attribute__((ext_vector_type(4)));
typedef unsigned u32x2 __attribute__((ext_vector_type(2)));

constexpr int MTOT = 98304, NLAYER = 4;
constexpr size_t WL_ELEMS = 20971520;
constexpr size_t WO_WI1 = 0, WO_WO1 = 5767168, WO_WI2 = 8650752, WO_WO2 = 14417920, WO_WINA = 17301504, WO_WINB = 18087936, WO_WOUT = 19922944;
constexpr size_t OFF_W = 0;
constexpr size_t OFF_MOD = 167772160;
constexpr size_t OFF_ROPE = OFF_MOD + 4718592;
constexpr size_t OFF_H3 = OFF_ROPE + 262144;
constexpr size_t OFF_KF = OFF_H3 + 6291456;
constexpr int KS4 = 4104, KS2 = 2056;
constexpr size_t KF_LAYER = (size_t)512 * (KS4 + KS2);
constexpr size_t OFF_H = OFF_KF + 4 * KF_LAYER * 8;
constexpr size_t OFF_ACT = OFF_H + (size_t)MTOT * 1024 * 2;
constexpr size_t OFF_ZA = OFF_ACT;
constexpr size_t OFF_ZT = OFF_ACT + (size_t)MTOT * 768 * 2;
constexpr size_t WS_NEED = OFF_ACT + (size_t)MTOT * 2816 * 2;
static_assert(OFF_ZT + (size_t)1792 * MTOT * 2 <= WS_NEED, "mixer overlay fits");
constexpr int LDS_BYTES = 132096;
constexpr int NPHASE = 2 + 11 * NLAYER;
#ifndef EN_GEMM
#define EN_GEMM 1
#endif
#ifndef EN_LN
#define EN_LN 1
#endif
#ifndef EN_ATT
#define EN_ATT 1
#endif
#ifndef EN_HY
#define EN_HY 1
#endif
#ifndef EN_RMS
#define EN_RMS 1
#endif
#ifndef EN_P0
#define EN_P0 1
#endif
#ifndef EN_P1
#define EN_P1 1
#endif

struct Params { const float* in[28]; float* X; unsigned char* ws; int ph_lo, ph_hi; };
#define PIN (p.in + zl)
__device__ __forceinline__ int launder0() { int z = 0; asm volatile("" : "+s"(z)); return z; }

__device__ __forceinline__ float bf_lo(unsigned u) { return __uint_as_float(u << 16); }
__device__ __forceinline__ float bf_hi(unsigned u) { return __uint_as_float(u & 0xffff0000u); }
__device__ __forceinline__ float bf2f(bf16_t b) { return __uint_as_float(((unsigned)b) << 16); }
__device__ __forceinline__ unsigned pk2(float lo, float hi) { return pg8::cvt_pk_bf16(lo, hi); }
__device__ __forceinline__ float sin_rev(float r) { return __builtin_amdgcn_sinf(r); }
__device__ __forceinline__ float cos_rev(float r) { return __builtin_amdgcn_cosf(r); }
__device__ __forceinline__ float sin_rad(float x) { float r = x * 0.15915494309189535f; r -= rintf(r); return __builtin_amdgcn_sinf(r); }
__device__ __forceinline__ float cos_rad(float x) { float r = x * 0.15915494309189535f; r -= rintf(r); return __builtin_amdgcn_cosf(r); }
__device__ __forceinline__ float wave_sum(float v) {
#pragma unroll
    for (int o = 1; o < 64; o <<= 1) v += __shfl_xor(v, o);
    return v;
}
__device__ __forceinline__ int row_bidx(int row) { return row < 65536 ? (row >> 12) : 16 + ((row - 65536) >> 11); }

__device__ __forceinline__ void cvt_tile(const float* __restrict__ src, int ldN, int k0, int c0, bf16_t* __restrict__ dst, int ldK, int n0, bool zero, float* tile) {
    const int tid = ltid();
    {
        const int r = tid >> 4, c4 = (tid & 15) * 4;
#pragma unroll
        for (int ps = 0; ps < 2; ++ps) {
            const int k = r + 32 * ps;
            f32x4 v = {0.f, 0.f, 0.f, 0.f};
            if (!zero) v = *(const f32x4*)(src + (size_t)(k0 + k) * ldN + c0 + c4);
            tile[k * 65 + c4 + 0] = v[0]; tile[k * 65 + c4 + 1] = v[1]; tile[k * 65 + c4 + 2] = v[2]; tile[k * 65 + c4 + 3] = v[3];
        }
    }
    __syncthreads();
    {
        const int n = tid >> 3, kq = tid & 7;
        float f[8];
#pragma unroll
        for (int j = 0; j < 8; ++j) f[j] = tile[(kq * 8 + j) * 65 + n];
        u32x4 pk; pk[0] = pk2(f[0], f[1]); pk[1] = pk2(f[2], f[3]); pk[2] = pk2(f[4], f[5]); pk[3] = pk2(f[6], f[7]);
        *(u32x4*)(dst + (size_t)(n0 + n) * ldK + k0 + kq * 8) = pk;
    }
    __syncthreads();
}

__device__ __forceinline__ void phase0a(const Params& p, unsigned char* smem) {
    const int zl = launder0(); unsigned char* const wsp = lptr(p.ws); float* const xp = lptr(p.X); (void)xp;
    const int tid = ltid();
    float* tile = (float*)smem;
    for (int t = blockIdx.x; t < 20480; t += gridDim.x) {
        const int l = t / 5120, r = t % 5120;
        bf16_t* wl = (bf16_t*)(wsp + OFF_W) + (size_t)l * WL_ELEMS;
        const float* src; int ldN, k0, c0, ldK, n0; bf16_t* dst; bool zero = false;
        if (r < 2816) {
            const int which = r / 1408, rr = r % 1408, nt = rr / 16, kt = rr % 16;
            src = PIN[which ? 8 : 6] + (size_t)l * 1024 * 5632; ldN = 5632; k0 = kt * 64; n0 = nt * 64;
            const int tt = n0 >> 8, within = n0 & 255;
            c0 = within < 128 ? 128 * tt + within : 2816 + 128 * tt + (within - 128);
            dst = wl + (which ? WO_WI2 : WO_WI1); ldK = 1024;
        } else if (r < 4224) {
            const int q = r - 2816, which = q / 704, rr = q % 704, nt = rr / 44, kt = rr % 44;
            src = PIN[which ? 9 : 7] + (size_t)l * 2816 * 1024; ldN = 1024; k0 = kt * 64; n0 = nt * 64; c0 = n0;
            dst = wl + (which ? WO_WO2 : WO_WO1); ldK = 2816;
        } else if (r < 4416) {
            const int q = r - 4224, nt = q / 16, kt = q % 16;
            src = PIN[12] + (size_t)l * 1024 * 2304; ldN = 2304; k0 = kt * 64; n0 = nt * 64; c0 = n0;
            dst = wl + WO_WINA; ldK = 1024;
        } else if (r < 4864) {
            const int q = r - 4416, nt = q / 16, kt = q % 16;
            src = PIN[12] + (size_t)l * 1024 * 2304; ldN = 2304; k0 = kt * 64; n0 = nt * 64;
            if (n0 < 1536) c0 = 768 + n0; else if (n0 < 1664) c0 = 640 + (n0 - 1536); else { c0 = 0; zero = true; }
            dst = wl + WO_WINB; ldK = 1024;
        } else {
            const int q = r - 4864, nt = q / 16, kt = q % 16;
            src = PIN[13] + (size_t)l * 1024 * 1024; ldN = 1024; k0 = kt * 64; n0 = nt * 64; c0 = n0;
            dst = wl + WO_WOUT; ldK = 1024;
        }
        cvt_tile(src, ldN, k0, c0, dst, ldK, n0, zero, tile);
    }
    {
        float* sc = (float*)smem;
        float* MOD = (float*)(wsp + OFF_MOD);
        for (int u = blockIdx.x; u < 288; u += gridDim.x) {
            const int l = u / 72, cch = u % 72;
            for (int idx = tid; idx < 32768; idx += 512) {
                const int b = idx >> 10, k = idx & 1023;
                const float c = b < 16 ? PIN[2][b * 1024 + k] : PIN[3][(b - 16) * 1024 + k];
                sc[k * 32 + b] = c / (1.0f + __expf(-c));
            }
            __syncthreads();
            const int cl = tid & 127, ks = tid >> 7, col = cch * 128 + cl;
            float acc[32];
#pragma unroll
            for (int b = 0; b < 32; ++b) acc[b] = 0.f;
            const float* wp = PIN[4] + ((size_t)l * 1024 + ks * 256) * 9216 + col;
            for (int k = 0; k < 256; ++k) {
                const float w = wp[(size_t)k * 9216];
                const f32x4* sp = (const f32x4*)(sc + (ks * 256 + k) * 32);
#pragma unroll
                for (int b4 = 0; b4 < 8; ++b4) { const f32x4 s = sp[b4]; acc[b4 * 4 + 0] += s[0] * w; acc[b4 * 4 + 1] += s[1] * w; acc[b4 * 4 + 2] += s[2] * w; acc[b4 * 4 + 3] += s[3] * w; }
            }
            __syncthreads();
            float* part = (float*)smem;
#pragma unroll
            for (int b = 0; b < 32; ++b) part[(ks * 32 + b) * 128 + cl] = acc[b];
            __syncthreads();
            for (int idx = tid; idx < 4096; idx += 512) {
                const int b = idx >> 7, c2 = idx & 127, cc = cch * 128 + c2;
                const float s = part[(0 * 32 + b) * 128 + c2] + part[(1 * 32 + b) * 128 + c2] + part[(2 * 32 + b) * 128 + c2] + part[(3 * 32 + b) * 128 + c2];
                MOD[((size_t)l * 32 + b) * 9216 + cc] = s + PIN[5][l * 9216 + cc];
            }
            __syncthreads();
        }
    }
    {
        float* zb = (float*)smem; float* ha = zb + 8 * 40; float* hb = ha + 8 * 64;
        float* H3 = (float*)(wsp + OFF_H3);
        for (int u = blockIdx.x; u < 384; u += gridDim.x) {
            const int l = u / 96, v = u % 96;
            const int Lsel = v >= 64, chunk = Lsel ? v - 64 : v, L = Lsel ? 2048 : 4096;
            const int lr = tid >> 6, j = tid & 63;
            const float fr = PIN[25][l * 64 + j];
            for (int it = 0; it < 8; ++it) {
                const int pos = chunk * 64 + it * 8 + lr;
                if (j < 33) {
                    const float tt = (float)pos / (float)(L - 1), w = (6.2831855f * (float)pos) / (float)L;
                    float val;
                    if (j == 0) val = tt;
                    else if (j <= 16) { const float fb = 1e-4f + (float)(j - 1) * 0.99999333f; val = cos_rad(fb * w); }
                    else { const float fb = 1e-4f + (float)(j - 17) * 0.99999333f; val = -sin_rad(fb * w); }
                    zb[lr * 40 + j] = val;
                }
                __syncthreads();
                float a = PIN[19][l * 64 + j];
                for (int i = 0; i < 33; ++i) a += zb[lr * 40 + i] * PIN[18][((size_t)l * 33 + i) * 64 + j];
                ha[lr * 64 + j] = sin_rad(fr * a);
                __syncthreads();
                a = PIN[21][l * 64 + j];
                for (int i = 0; i < 64; ++i) a += ha[lr * 64 + i] * PIN[20][((size_t)l * 64 + i) * 64 + j];
                hb[lr * 64 + j] = sin_rad(fr * a);
                __syncthreads();
                a = PIN[23][l * 64 + j];
                for (int i = 0; i < 64; ++i) a += hb[lr * 64 + i] * PIN[22][((size_t)l * 64 + i) * 64 + j];
                H3[((size_t)l * 6144 + (Lsel ? 4096 : 0) + pos) * 64 + j] = sin_rad(fr * a);
                __syncthreads();
            }
        }
    }
    {
        const double INV[8] = {1.0, 0.19392274474868576, 0.03760603093086393, 0.007292664737217109, 0.001414213562373095, 0.0002742481756762073, 5.318295896944988e-05, 1.031338537721246e-05};
        float2* rope = (float2*)(wsp + OFF_ROPE);
        for (int idx = blockIdx.x * 512 + tid; idx < 32768; idx += gridDim.x * 512) {
            const int pos = idx >> 3, i = idx & 7;
            double inv = INV[0];
#pragma unroll
            for (int q = 1; q < 8; ++q) inv = (i == q) ? INV[q] : inv;
            double r = (double)pos * inv * 0.15915494309189535; r -= rint(r);
            const float rf = (float)r;
            rope[idx] = make_float2(cos_rev(rf), sin_rev(rf));
        }
    }
}

__device__ __forceinline__ void fft_fwd(float2* buf, int logN, int tid) {
    const int N = 1 << logN;
    for (int s = 0; s < logN; ++s) {
        const int half = N >> (s + 1); const float inv2h = 1.0f / (float)(2 * half);
        for (int j = tid; j < (N >> 1); j += 512) {
            const int pos = j & (half - 1), i0 = 2 * j - pos, i1 = i0 + half;
            const float2 a = buf[i0], b = buf[i1];
            const float fr = (float)pos * inv2h, c = cos_rev(fr), sn = sin_rev(fr);
            const float dx = a.x - b.x, dy = a.y - b.y;
            buf[i0] = make_float2(a.x + b.x, a.y + b.y);
            buf[i1] = make_float2(dx * c + dy * sn, dy * c - dx * sn);
        }
        __syncthreads();
    }
}
__device__ __forceinline__ void fft_inv(float2* buf, int logN, int tid) {
    const int N = 1 << logN;
    for (int s = logN - 1; s >= 0; --s) {
        const int half = N >> (s + 1); const float inv2h = 1.0f / (float)(2 * half);
        for (int j = tid; j < (N >> 1); j += 512) {
            const int pos = j & (half - 1), i0 = 2 * j - pos, i1 = i0 + half;
            const float2 a = buf[i0], b = buf[i1];
            const float fr = (float)pos * inv2h, c = cos_rev(fr), sn = sin_rev(fr);
            const float tx = b.x * c - b.y * sn, ty = b.y * c + b.x * sn;
            buf[i0] = make_float2(a.x + tx, a.y + ty);
            buf[i1] = make_float2(a.x - tx, a.y - ty);
        }
        __syncthreads();
    }
}

__device__ __forceinline__ void phase0b(const Params& p, unsigned char* smem) {
    const int zl = launder0(); unsigned char* const wsp = lptr(p.ws); float* const xp = lptr(p.X); (void)xp;
    const int tid = ltid(), lane = tid & 63, w = tid >> 6;
    float2* buf = (float2*)smem; float* w4s = (float*)(smem + 65536);
    const float* H3 = (const float*)(wsp + OFF_H3);
    float2* KF = (float2*)(wsp + OFF_KF);
    for (int v = blockIdx.x; v < 2048; v += gridDim.x) {
        const int l = v >> 9, ww = v & 511, Lsel = ww >> 8, cp = ww & 255;
        const int L = Lsel ? 2048 : 4096, logN = Lsel ? 12 : 13, N = 2 * L;
        if (tid < 256) { const int i = tid >> 2, q = tid & 3; w4s[tid] = PIN[24][((size_t)l * 64 + i) * 1024 + (q >> 1) * 512 + 2 * cp + (q & 1)]; }
        const float d00 = fabsf(PIN[26][(l * 2 + 0) * 512 + 2 * cp]), d01 = fabsf(PIN[26][(l * 2 + 0) * 512 + 2 * cp + 1]);
        const float d10 = fabsf(PIN[26][(l * 2 + 1) * 512 + 2 * cp]), d11 = fabsf(PIN[26][(l * 2 + 1) * 512 + 2 * cp + 1]);
        __syncthreads();
        for (int pos = tid; pos < L; pos += 512) {
            const f32x4* hrow = (const f32x4*)(H3 + ((size_t)l * 6144 + (Lsel ? 4096 : 0) + pos) * 64);
            float a0 = 0.f, a1 = 0.f, a2 = 0.f, a3 = 0.f;
#pragma unroll
            for (int i4 = 0; i4 < 16; ++i4) {
                const f32x4 h = hrow[i4];
#pragma unroll
                for (int e = 0; e < 4; ++e) { const f32x4 wv = *(const f32x4*)(w4s + (i4 * 4 + e) * 4); a0 += h[e] * wv[0]; a1 += h[e] * wv[1]; a2 += h[e] * wv[2]; a3 += h[e] * wv[3]; }
            }
            const float tt = (float)pos / (float)(L - 1);
            const float hf1 = a0 * __expf(-tt * d00), hf2 = a1 * __expf(-tt * d01), hb1 = a2 * __expf(-tt * d10), hb2 = a3 * __expf(-tt * d11);
            if (pos == 0) { buf[0] = make_float2(hf1 + hb1, hf2 + hb2); buf[L] = make_float2(0.f, 0.f); }
            else { buf[pos] = make_float2(hf1, hf2); buf[N - pos] = make_float2(hb1, hb2); }
        }
        __syncthreads();
        fft_fwd(buf, logN, tid);
        const float sc = 0.25f / (float)N;
        float2* K1 = KF + (size_t)l * KF_LAYER + (Lsel ? (size_t)512 * KS4 + (size_t)(2 * cp) * KS2 : (size_t)(2 * cp) * KS4);
        float2* K2 = K1 + (Lsel ? KS2 : KS4);
        for (int k = tid; k <= L; k += 512) {
            const int pa = (int)(__brev((unsigned)k) >> (32 - logN)), pb = (int)(__brev((unsigned)((N - k) & (N - 1))) >> (32 - logN));
            const float2 a = buf[pa], b = buf[pb];
            K1[k] = make_float2((a.x + b.x) * sc, (a.y - b.y) * sc);
            K2[k] = make_float2((a.y + b.y) * sc, -(a.x - b.x) * sc);
        }
        __syncthreads();
    }
    {
        const float* MOD = (const float*)(wsp + OFF_MOD);
        bf16_t* H = (bf16_t*)(wsp + OFF_H);
        for (int row = blockIdx.x * 8 + w; row < MTOT; row += gridDim.x * 8) {
            const float* src = row < 65536 ? PIN[0] + (size_t)row * 1024 : PIN[1] + (size_t)(row - 65536) * 1024;
            const float* md = MOD + (size_t)row_bidx(row) * 9216;
#pragma unroll
            for (int i = 0; i < 4; ++i) {
                const int col = i * 256 + lane * 4;
                const f32x4 v = *(const f32x4*)(src + col), sh = *(const f32x4*)(md + col), scl = *(const f32x4*)(md + 1024 + col);
                *(f32x4*)(xp + (size_t)row * 1024 + col) = v;
                const f32x4 h = v * (scl + 1.0f) + sh;
                u32x2 pk; pk[0] = pk2(h[0], h[1]); pk[1] = pk2(h[2], h[3]);
                *(u32x2*)(H + (size_t)row * 1024 + col) = pk;
            }
        }
    }
}

__device__ __forceinline__ void lnmod_phase(unsigned char* wsp, float* xp, const float* __restrict__ g, const float* __restrict__ bb, const float* __restrict__ modbase  ) {
    const int tid = ltid(), lane = tid & 63, w = tid >> 6;
    bf16_t* H = (bf16_t*)(wsp + OFF_H);
    for (int row = blockIdx.x * 8 + w; row < MTOT; row += gridDim.x * 8) {
        float* xr = xp + (size_t)row * 1024;
        f32x4 v[4];
        float s = 0.f;
#pragma unroll
        for (int i = 0; i < 4; ++i) { v[i] = *(const f32x4*)(xr + i * 256 + lane * 4); s += v[i][0] + v[i][1] + v[i][2] + v[i][3]; }
        const float mean = wave_sum(s) * (1.0f / 1024.0f);
        float q = 0.f;
#pragma unroll
        for (int i = 0; i < 4; ++i) { const f32x4 d = v[i] - mean; q += d[0] * d[0] + d[1] * d[1] + d[2] * d[2] + d[3] * d[3]; }
        const float rstd = rsqrtf(wave_sum(q) * (1.0f / 1024.0f) + 1e-5f);
        const float* md = modbase ? modbase + (size_t)row_bidx(row) * 9216 : nullptr;
#pragma unroll
        for (int i = 0; i < 4; ++i) {
            const int col = i * 256 + lane * 4;
            const f32x4 gg = *(const f32x4*)(g + col), be = *(const f32x4*)(bb + col);
            const f32x4 xn = (v[i] - mean) * rstd * gg + be;
            *(f32x4*)(xr + col) = xn;
            if (md) {
                const f32x4 sh = *(const f32x4*)(md + col), scl = *(const f32x4*)(md + 1024 + col);
                const f32x4 h = xn * (scl + 1.0f) + sh;
                u32x2 pk; pk[0] = pk2(h[0], h[1]); pk[1] = pk2(h[2], h[3]);
                *(u32x2*)(H + (size_t)row * 1024 + col) = pk;
            }
        }
    }
}

__device__ __forceinline__ u32x4 rope_apply(u32x4 mine, u32x4 other, const float2* __restrict__ tab, int second) {
    u32x4 out;
#pragma unroll
    for (int q = 0; q < 4; ++q) {
        const f32x4 cs = *(const f32x4*)(tab + 2 * q);
        const float m0 = bf_lo(mine[q]), m1 = bf_hi(mine[q]), o0 = bf_lo(other[q]), o1 = bf_hi(other[q]);
        const float r0 = second ? m0 * cs[0] + o0 * cs[1] : m0 * cs[0] - o0 * cs[1];
        const float r1 = second ? m1 * cs[2] + o1 * cs[3] : m1 * cs[2] - o1 * cs[3];
        out[q] = pk2(r0, r1);
    }
    return out;
}

__device__ __forceinline__ void attn_unit(const Params& p, int l, int ua, unsigned char* smem) {
    const int zl = launder0(); unsigned char* const wsp = lptr(p.ws); float* const xp = lptr(p.X); (void)xp;
    const int tid = ltid(), lane = tid & 63, w = tid >> 6;
    const int qb = ua >> 1, g = ua & 1;
    int blk, nb;
    if (qb < 512) { blk = qb & 31; nb = 32; } else { blk = (qb - 512) & 15; nb = 16; }
    const int row0 = qb * 128, pos0 = blk * 128;
    const bool hasPrev = blk > 0, hasNext = blk < nb - 1;
    const bf16_t* ZA = (const bf16_t*)(wsp + OFF_ZA);
    const bf16_t* ZT = (const bf16_t*)(wsp + OFF_ZT);
    bf16_t* A2 = (bf16_t*)(wsp + OFF_H);
    const float2* rope = (const float2*)(wsp + OFF_ROPE);
    unsigned char* Ks = smem;
    unsigned char* Vs = smem + 55296;
#pragma unroll
    for (int i = 0; i < 6; ++i) {
        const int idx = tid + 512 * i, kb = idx >> 3, part = idx & 7, b3 = kb >> 7;
        const bool valid = (b3 == 1) || (b3 == 0 && hasPrev) || (b3 == 2 && hasNext);
        u32x4 v = {0u, 0u, 0u, 0u};
        if (valid) {
            const bf16_t* src = ZA + (size_t)(row0 - 128 + kb) * 768 + 512 + g * 64;
            v = *(const u32x4*)(src + part * 8);
            if (part < 2) { const u32x4 o = *(const u32x4*)(src + (part ^ 1) * 8); v = rope_apply(v, o, rope + (size_t)(pos0 - 128 + kb) * 8, part); }
        }
        *(u32x4*)(Ks + kb * 144 + part * 16) = v;
    }
#pragma unroll
    for (int i = 0; i < 6; ++i) {
        const int idx = tid + 512 * i, d = idx / 48, part = idx % 48, kb0 = part * 8, b3 = kb0 >> 7;
        const bool valid = (b3 == 1) || (b3 == 0 && hasPrev) || (b3 == 2 && hasNext);
        u32x4 v = {0u, 0u, 0u, 0u};
        if (valid) v = *(const u32x4*)(ZT + (size_t)(1536 + g * 64 + d) * MTOT + row0 - 128 + kb0);
        *(u32x4*)(Vs + d * 784 + part * 16) = v;
    }
    __syncthreads();
    const int hh = w >> 1, head = g * 4 + hh;
    const float sinkv = PIN[14][l * 8 + head];
    const int r = lane & 31, h = lane >> 5;
    for (int qt = 0; qt < 2; ++qt) {
        const int qi = (w & 1) * 2 + qt;
        const int qrow = row0 + 32 * qi + r, qpos = pos0 + 32 * qi + r;
        const bf16_t* qsrc = ZA + (size_t)qrow * 768 + head * 64;
        bf16x8 qf[4];
#pragma unroll
        for (int s = 0; s < 4; ++s) {
            u32x4 v = *(const u32x4*)(qsrc + 16 * s + 8 * h);
            if (s == 0) { const u32x4 o = *(const u32x4*)(qsrc + 8 * (1 - h)); v = rope_apply(v, o, rope + (size_t)qpos * 8, h); }
#pragma unroll
            for (int q = 0; q < 4; ++q) v[q] = pk2(bf_lo(v[q]) * 0.125f, bf_hi(v[q]) * 0.125f);
            qf[s] = __builtin_bit_cast(bf16x8, v);
        }
        float mrun = sinkv, lsum = 1.0f;
        f32x16 O[2];
#pragma unroll
        for (int dt = 0; dt < 2; ++dt)
#pragma unroll
            for (int e = 0; e < 16; ++e) O[dt][e] = 0.f;
#pragma nounroll
        for (int ch = 0; ch < 3; ++ch) {
            f32x16 S[3];
#pragma unroll
            for (int c = 0; c < 3; ++c) {
#pragma unroll
                for (int e = 0; e < 16; ++e) S[c][e] = 0.f;
                const unsigned char* kp = Ks + (32 * (qi + 3 * ch + c) + r) * 144 + h * 16;
#pragma unroll
                for (int s = 0; s < 4; ++s) { const bf16x8 kf = *(const bf16x8*)(kp + s * 32); S[c] = __builtin_amdgcn_mfma_f32_32x32x16_bf16(kf, qf[s], S[c], 0, 0, 0); }
            }
            float cmax = -1e30f;
#pragma unroll
            for (int c = 0; c < 3; ++c) {
                const int tp = 3 * ch + c, b3 = (qi + tp) >> 2;
                const bool tv = (b3 == 1) || (b3 == 0 && hasPrev) || (b3 == 2 && hasNext);
#pragma unroll
                for (int e = 0; e < 16; ++e) {
                    const int kk = (e & 3) + 8 * (e >> 2) + 4 * h;
                    bool ok = tv;
                    if (c == 0) ok = ok && (tp != 0 || kk >= r);
                    if (c == 2) ok = ok && (tp != 8 || kk <= r);
                    const float sv = ok ? S[c][e] : -1e30f;
                    S[c][e] = sv; cmax = fmaxf(cmax, sv);
                }
            }
            cmax = fmaxf(cmax, __shfl_xor(cmax, 32));
            const float mnew = fmaxf(mrun, cmax), scl = __expf(mrun - mnew);
            mrun = mnew;
            float psum = 0.f;
#pragma unroll
            for (int c = 0; c < 3; ++c)
#pragma unroll
                for (int e = 0; e < 16; ++e) { const float pv = __expf(S[c][e] - mnew); S[c][e] = pv; psum += pv; }
            psum += __shfl_xor(psum, 32);
            lsum = lsum * scl + psum;
#pragma unroll
            for (int dt = 0; dt < 2; ++dt)
#pragma unroll
                for (int e = 0; e < 16; ++e) O[dt][e] *= scl;
#pragma unroll
            for (int c = 0; c < 3; ++c)
#pragma unroll
                for (int s2 = 0; s2 < 2; ++s2) {
                    u32x4 pp; pp[0] = pk2(S[c][8 * s2 + 0], S[c][8 * s2 + 1]); pp[1] = pk2(S[c][8 * s2 + 2], S[c][8 * s2 + 3]); pp[2] = pk2(S[c][8 * s2 + 4], S[c][8 * s2 + 5]); pp[3] = pk2(S[c][8 * s2 + 6], S[c][8 * s2 + 7]);
                    const bf16x8 pf = __builtin_bit_cast(bf16x8, pp);
#pragma unroll
                    for (int dt = 0; dt < 2; ++dt) {
                        const unsigned char* vp = Vs + (32 * dt + r) * 784 + (32 * (qi + 3 * ch + c) + 16 * s2 + 4 * h) * 2;
                        const u32x2 lo = *(const u32x2*)vp, hi = *(const u32x2*)(vp + 16);
                        u32x4 vv; vv[0] = lo[0]; vv[1] = lo[1]; vv[2] = hi[0]; vv[3] = hi[1];
                        O[dt] = __builtin_amdgcn_mfma_f32_32x32x16_bf16(__builtin_bit_cast(bf16x8, vv), pf, O[dt], 0, 0, 0);
                    }
                }
        }
        const float inv = 1.0f / lsum;
        bf16_t* op = A2 + (size_t)qrow * 1024 + head * 64;
#pragma unroll
        for (int dt = 0; dt < 2; ++dt)
#pragma unroll
            for (int gq = 0; gq < 4; ++gq) {
                u32x2 o; o[0] = pk2(O[dt][4 * gq + 0] * inv, O[dt][4 * gq + 1] * inv); o[1] = pk2(O[dt][4 * gq + 2] * inv, O[dt][4 * gq + 3] * inv);
                *(u32x2*)(op + 32 * dt + 8 * gq + 4 * h) = o;
            }
    }
    __syncthreads();
}

__device__ __forceinline__ void hyena_unit(const Params& p, int l, int hu, unsigned char* smem) {
    const int zl = launder0(); unsigned char* const wsp = lptr(p.ws); float* const xp = lptr(p.X); (void)xp;
    const int tid = ltid();
    const int bidx = hu >> 8, cp = hu & 255, c1 = 2 * cp;
    const int L = bidx < 16 ? 4096 : 2048, logN = bidx < 16 ? 13 : 12, N = 2 * L;
    const size_t rb = bidx < 16 ? (size_t)bidx * 4096 : 65536 + (size_t)(bidx - 16) * 2048;
    float2* buf = (float2*)smem;
    bf16_t* ZT = (bf16_t*)(wsp + OFF_ZT);
    const float* cw = PIN[16] + (size_t)l * 3 * 1536; const float* cb = PIN[17] + (size_t)l * 1536;
    const int t8 = tid * 8; const bool act = t8 < L;
    float u[2][8], x0c[2][8];
    if (act) {
#pragma unroll
        for (int cc = 0; cc < 2; ++cc) {
            float cv[3][8];
#pragma unroll
            for (int gi = 0; gi < 3; ++gi) {
                const int col = gi * 512 + c1 + cc;
                const bf16_t* src = ZT + (size_t)col * MTOT + rb + t8;
                const u32x4 raw = *(const u32x4*)src;
                float in[10];
                in[0] = t8 > 0 ? bf2f(src[-1]) : 0.f;
                in[9] = (t8 + 8 < L) ? bf2f(src[8]) : 0.f;
#pragma unroll
                for (int q = 0; q < 4; ++q) { in[1 + 2 * q] = bf_lo(raw[q]); in[2 + 2 * q] = bf_hi(raw[q]); }
                const float w0 = cw[col], w1 = cw[1536 + col], w2 = cw[3072 + col], bsv = cb[col];
#pragma unroll
                for (int j = 0; j < 8; ++j) cv[gi][j] = w0 * in[j] + w1 * in[j + 1] + w2 * in[j + 2] + bsv;
            }
#pragma unroll
            for (int j = 0; j < 8; ++j) { u[cc][j] = cv[2][j] * cv[1][j]; x0c[cc][j] = cv[0][j]; }
        }
#pragma unroll
        for (int j = 0; j < 8; ++j) { buf[t8 + j] = make_float2(u[0][j], u[1][j]); buf[L + t8 + j] = make_float2(0.f, 0.f); }
    }
    __syncthreads();
    fft_fwd(buf, logN, tid);
    {
        const float2* KF = (const float2*)(wsp + OFF_KF);
        const float2* K1 = KF + (size_t)l * KF_LAYER + (bidx < 16 ? (size_t)c1 * KS4 : (size_t)512 * KS4 + (size_t)c1 * KS2);
        const float2* K2 = K1 + (bidx < 16 ? KS4 : KS2);
        for (int k = tid; k <= L; k += 512) {
            const int pa = (int)(__brev((unsigned)k) >> (32 - logN)), pb = (int)(__brev((unsigned)((N - k) & (N - 1))) >> (32 - logN));
            const float2 a = buf[pa], b = buf[pb];
            const float u1x = a.x + b.x, u1y = a.y - b.y, u2x = a.y + b.y, u2y = b.x - a.x;
            const float2 k1 = K1[k], k2 = K2[k];
            const float p1x = u1x * k1.x - u1y * k1.y, p1y = u1x * k1.y + u1y * k1.x;
            const float p2x = u2x * k2.x - u2y * k2.y, p2y = u2x * k2.y + u2y * k2.x;
            buf[pa] = make_float2(p1x - p2y, p1y + p2x);
            if (pb != pa) buf[pb] = make_float2(p1x + p2y, p2x - p1y);
        }
    }
    __syncthreads();
    fft_inv(buf, logN, tid);
    if (act) {
#pragma unroll
        for (int cc = 0; cc < 2; ++cc) {
            const float bias = PIN[27][l * 512 + c1 + cc];
            float o[8];
#pragma unroll
            for (int j = 0; j < 8; ++j) { const float2 y = buf[t8 + j]; o[j] = ((cc ? y.y : y.x) + u[cc][j] * bias) * x0c[cc][j]; }
            u32x4 pk; pk[0] = pk2(o[0], o[1]); pk[1] = pk2(o[2], o[3]); pk[2] = pk2(o[4], o[5]); pk[3] = pk2(o[6], o[7]);
            *(u32x4*)(ZT + (size_t)(c1 + cc) * MTOT + rb + t8) = pk;
        }
    }
    __syncthreads();
}

__device__ __forceinline__ void rms_unit(const Params& p, int l, int rc, unsigned char* smem) {
    const int zl = launder0(); unsigned char* const wsp = lptr(p.ws); float* const xp = lptr(p.X); (void)xp;
    const int tid = ltid(), lane = tid & 63, w = tid >> 6;
    const int row0 = rc * 64;
    bf16_t* A2 = (bf16_t*)(wsp + OFF_H);
    const bf16_t* ZT = (const bf16_t*)(wsp + OFF_ZT);
    const float* gn = PIN[15] + (size_t)l * 1024;
    for (int rr = 0; rr < 8; ++rr) {
        bf16_t* ap = A2 + (size_t)(row0 + w * 8 + rr) * 1024 + lane * 8;
        const u32x4 v = *(const u32x4*)ap;
        float x[8];
#pragma unroll
        for (int q = 0; q < 4; ++q) { x[2 * q] = bf_lo(v[q]); x[2 * q + 1] = bf_hi(v[q]); }
        float ss = 0.f;
#pragma unroll
        for (int j = 0; j < 8; ++j) ss += x[j] * x[j];
        const float rstd = rsqrtf(wave_sum(ss) * (1.0f / 512.0f) + 1e-6f);
        const f32x4 g0 = *(const f32x4*)(gn + lane * 8), g1 = *(const f32x4*)(gn + lane * 8 + 4);
        u32x4 pk; pk[0] = pk2(x[0] * rstd * g0[0], x[1] * rstd * g0[1]); pk[1] = pk2(x[2] * rstd * g0[2], x[3] * rstd * g0[3]);
        pk[2] = pk2(x[4] * rstd * g1[0], x[5] * rstd * g1[1]); pk[3] = pk2(x[6] * rstd * g1[2], x[7] * rstd * g1[3]);
        *(u32x4*)ap = pk;
    }
    bf16_t* T = (bf16_t*)smem;
    {
        const int c = tid;
#pragma unroll
        for (int q = 0; q < 8; ++q) {
            const u32x4 v = *(const u32x4*)(ZT + (size_t)c * MTOT + row0 + q * 8);
#pragma unroll
            for (int e = 0; e < 4; ++e) { T[(q * 8 + 2 * e) * 520 + c] = (bf16_t)(v[e] & 0xffffu); T[(q * 8 + 2 * e + 1) * 520 + c] = (bf16_t)(v[e] >> 16); }
        }
    }
    __syncthreads();
    for (int rr = 0; rr < 8; ++rr) {
        const int tok = w * 8 + rr;
        const u32x4 v = *(const u32x4*)(T + tok * 520 + lane * 8);
        float x[8];
#pragma unroll
        for (int q = 0; q < 4; ++q) { x[2 * q] = bf_lo(v[q]); x[2 * q + 1] = bf_hi(v[q]); }
        float ss = 0.f;
#pragma unroll
        for (int j = 0; j < 8; ++j) ss += x[j] * x[j];
        const float rstd = rsqrtf(wave_sum(ss) * (1.0f / 512.0f) + 1e-6f);
        const f32x4 g0 = *(const f32x4*)(gn + 512 + lane * 8), g1 = *(const f32x4*)(gn + 512 + lane * 8 + 4);
        u32x4 pk; pk[0] = pk2(x[0] * rstd * g0[0], x[1] * rstd * g0[1]); pk[1] = pk2(x[2] * rstd * g0[2], x[3] * rstd * g0[3]);
        pk[2] = pk2(x[4] * rstd * g1[0], x[5] * rstd * g1[1]); pk[3] = pk2(x[6] * rstd * g1[2], x[7] * rstd * g1[3]);
        *(u32x4*)(A2 + (size_t)(row0 + tok) * 1024 + 512 + lane * 8) = pk;
    }
    __syncthreads();
}

__global__ void __launch_bounds__(512) hymba_fwd(Params p) {
    extern __shared__ __attribute__((aligned(16))) unsigned char smem[];
    cg::grid_group grid = cg::this_grid();
    PG8_LAS unsigned char* lds = (PG8_LAS unsigned char*)smem;
    const int G = gridDim.x, wg = blockIdx.x;
    for (int ph = p.ph_lo; ph < p.ph_hi; ++ph) {
        const int zl = launder0(); unsigned char* const wsp = lptr(p.ws); float* const xp = lptr(p.X);
        bf16_t* Hb = (bf16_t*)(wsp + OFF_H); bf16_t* ACT = (bf16_t*)(wsp + OFF_ACT); float* MOD = (float*)(wsp + OFF_MOD);
        if (EN_P0 && ph == 0) phase0a(p, smem);
        else if (EN_P1 && ph == 1) phase0b(p, smem);
        else {
            const int l = (ph - 2) / 11, s = (ph - 2) % 11;
            const bf16_t* wl = (const bf16_t*)(wsp + OFF_W) + (size_t)l * WL_ELEMS;
            if (EN_GEMM && (s == 0 || s == 8 || s == 1 || s == 9 || s == 3 || s == 6)) {
                const int nsub = (s == 3) ? 2 : 1;
                for (int sub = 0; sub < nsub; ++sub) {
                    pg8::Gemm g; pg8::EpiAny E;
                    E.O = ACT; E.ldc = 2816; E.X = xp; E.gate = MOD; E.coef = 0.5f; E.mode = 0; E.perm = true;
                    if (s == 0 || s == 8) { g.A = Hb; g.Bt = wl + (s ? WO_WI2 : WO_WI1); g.M = MTOT; g.N = 5632; g.K = 1024; }
                    else if (s == 1 || s == 9) { g.A = ACT; g.Bt = wl + (s == 9 ? WO_WO2 : WO_WO1); g.M = MTOT; g.N = 1024; g.K = 2816;
                        E.mode = 1; E.perm = false; E.gate = MOD + (size_t)l * 32 * 9216 + (s == 9 ? 8 : 2) * 1024; }
                    else if (s == 6) { g.A = Hb; g.Bt = wl + WO_WOUT; g.M = MTOT; g.N = 1024; g.K = 1024;
                        E.mode = 1; E.perm = false; E.gate = MOD + (size_t)l * 32 * 9216 + 5 * 1024; E.coef = 1.0f; }
                    else if (sub == 0) { g.A = Hb; g.Bt = wl + WO_WINA; g.M = MTOT; g.N = 768; g.K = 1024; E.mode = 2; E.O = (bf16_t*)(wsp + OFF_ZA); E.ldc = 768; }
                    else { g.A = wl + WO_WINB; g.Bt = Hb; g.M = 1792; g.N = MTOT; g.K = 1024; E.mode = 2; E.O = (bf16_t*)(wsp + OFF_ZT); E.ldc = (size_t)MTOT; }
                    pg8::StaticOrder S; S.init(g.M, g.N, G, wg);
                    pg8::gemm_phase<pg8::EpiAny, pg8::StaticOrder>(lds, g, S, E, nullptr);
                }
            } else if (EN_LN && (s == 2 || s == 7 || s == 10)) {
                const int li = s == 2 ? 0 : (s == 7 ? 1 : 2);
                const float* md = nullptr;
                if (s == 2) md = MOD + (size_t)l * 32 * 9216 + 3 * 1024;
                else if (s == 7) md = MOD + (size_t)l * 32 * 9216 + 6 * 1024;
                else if (l + 1 < NLAYER) md = MOD + (size_t)(l + 1) * 32 * 9216;
                lnmod_phase(wsp, xp, PIN[10] + (size_t)(l * 3 + li) * 1024, PIN[11] + (size_t)(l * 3 + li) * 1024, md);
            } else if (s == 4) {
                if (EN_ATT) for (int ua = wg; ua < 1536; ua += G) attn_unit(p, l, ua, smem);
                if (EN_HY) for (int hu = wg; hu < 8192; hu += G) hyena_unit(p, l, hu, smem);
            } else if (EN_RMS && s == 5) {
                for (int rc = wg; rc < 1536; rc += G) rms_unit(p, l, rc, smem);
            }
        }
        if (ph + 1 < p.ph_hi) grid.sync();
    }
}

extern "C" void kernel_launch(void* const* d_in, const int* in_sizes, int n_in, void* d_out, int out_size, void* d_ws, size_t ws_size, hipStream_t stream) {
    static int grid = 0;
    if (grid == 0) {
        if (n_in != 28 || ws_size < WS_NEED) { fprintf(stderr, "kernel_launch: unexpected n_in %d or ws_size %zu (need %zu)\n", n_in, ws_size, (size_t)WS_NEED); grid = -1; return; }
        int dev = 0, cus = 0, per_cu = 0;
        (void)hipGetDevice(&dev);
        (void)hipDeviceGetAttribute(&cus, hipDeviceAttributeMultiprocessorCount, dev);
        if (hipFuncSetAttribute((const void*)hymba_fwd, hipFuncAttributeMaxDynamicSharedMemorySize, LDS_BYTES) != hipSuccess) { fprintf(stderr, "kernel_launch: hipFuncSetAttribute failed\n"); grid = -1; return; }
        if (hipOccupancyMaxActiveBlocksPerMultiprocessor(&per_cu, (const void*)hymba_fwd, 512, LDS_BYTES) != hipSuccess || per_cu < 1) { fprintf(stderr, "kernel_launch: occupancy query gave %d\n", per_cu); per_cu = 1; }
        (void)hipGetLastError();
        grid = cus * 1;
        if (grid <= 0) grid = 256;
    }
    if (grid < 0) return;
    Params p{};
    for (int i = 0; i < 28; ++i) p.in[i] = (const float*)d_in[i];
    p.X = (float*)d_out; p.ws = (unsigned char*)d_ws; p.ph_lo = 0; p.ph_hi = NPHASE;
    void* args[] = {&p};
    hipError_t e = hipLaunchCooperativeKernel((const void*)hymba_fwd, dim3(grid), dim3(512), args, LDS_BYTES, stream);
    if (e != hipSuccess) fprintf(stderr, "kernel_launch: cooperative launch failed: %s (grid %d)\n", hipGetErrorString(e), grid);
}
```

```cpp
#include <hip/hip_runtime.h>
#include <hip/hip_cooperative_groups.h>
#include <cstdio>
#include <cstdint>
namespace cg = cooperative_groups;
__device__ __forceinline__ int ltid() { int t = threadIdx.x; asm volatile("" : "+v"(t)); return t; }
template <class T> __device__ __forceinline__ T* lptr(T* q) { int z = 0; asm volatile("" : "+s"(z)); return q + z; }
namespace pg8 {
#define PG8_LAS __attribute__((address_space(3)))
typedef unsigned short bf16_t;
typedef short bf16x8 __attribute__((ext_vector_type(8)));
typedef float f32x4 __attribute__((ext_vector_type(4)));
typedef unsigned u32x4 __attribute__((ext_vector_type(4)));
constexpr int BM = 256, BK = 64, HALF = 128, HTB = HALF * BK * 2  , STAGE_BYTES = 8 * HTB, NXCD = 8, WGM = 8;

__host__ __device__ __forceinline__ int lds_byte(int r, int c) { const int st = (r >> 4) * 2 + (c >> 5), rr = r & 15, cc = c & 31, ob = rr * 64 + cc * 2; return st * 1024 + (ob ^ (((ob >> 9) & 1) << 5)); }
__host__ __device__ __forceinline__ void stage_rc(int b, int& R, int& C) { const int st = b / 1024, sb = b % 1024, swz = sb ^ (((sb >> 9) & 1) << 5); R = (st >> 1) * 16 + swz / 64; C = (st & 1) * 32 + (swz % 64) / 2; }
__host__ __device__ __forceinline__ int perm32(int rho) { const int n = rho >> 4, i = rho & 15; return 8 * (i >> 2) + 4 * n + (i & 3); }

struct Unit { int pm, pn; };
struct Gemm { const bf16_t* A; const bf16_t* Bt; int M, N, K; };
struct StaticOrder {
    int nM, nN, nwg, G, c;
    __host__ __device__ void init(int M, int N, int G_, int c_) { nM = M / BM; nN = N / BM; nwg = nM * nN; G = G_; c = c_; }
    __host__ __device__ bool next(int i, Unit& u) const {
        const long L = (long)i * G + c; if (L >= nwg) return false;
        int wgid = (int)L; { const int q = nwg / NXCD, r = nwg % NXCD, xcd = wgid % NXCD, off = wgid / NXCD; wgid = (xcd < r ? xcd * (q + 1) : r * (q + 1) + (xcd - r) * q) + off; }
        const int nig = WGM * nN, gid = wgid / nig, fm = gid * WGM, gsz = (nM - fm) < WGM ? (nM - fm) : WGM;
        u.pm = fm + ((wgid % nig) % gsz); u.pn = (wgid % nig) / gsz; return true;
    }
    __device__ __forceinline__ void a_ready(const Unit&) const {}
    __device__ __forceinline__ void done(const Unit&) const {}
};
__device__ __forceinline__ unsigned cvt_pk_bf16(float lo, float hi) { unsigned r; asm volatile("v_cvt_pk_bf16_f32 %0, %1, %2" : "=v"(r) : "v"(lo), "v"(hi)); return r; }
struct EpiSwiGLU {
    static constexpr bool PERM = true, AFTER_DRAIN = false;
    bf16_t* O;
    __device__ __forceinline__ void operator()(const f32x4 (&acc)[2][2][4][2], const Unit& u, int wr, int wc, int fr, int fq) const {
        const int row0 = u.pm * BM + wr * 64 + fr, col0 = u.pn * 128 + wc * 32 + 8 * fq;
#pragma unroll
        for (int ai = 0; ai < 2; ++ai)
#pragma unroll
            for (int m = 0; m < 4; ++m) {
                bf16_t* p = O + (size_t)(row0 + ai * HALF + m * 16) * 2816 + col0;
                float v[8];
#pragma unroll
                for (int n = 0; n < 2; ++n)
#pragma unroll
                    for (int j = 0; j < 4; ++j) { const float g = acc[ai][0][m][n][j], uu = acc[ai][1][m][n][j]; v[n * 4 + j] = g * uu * __builtin_amdgcn_rcpf(1.0f + __expf(-g)); }
                u32x4 pk; pk[0] = cvt_pk_bf16(v[0], v[1]); pk[1] = cvt_pk_bf16(v[2], v[3]); pk[2] = cvt_pk_bf16(v[4], v[5]); pk[3] = cvt_pk_bf16(v[6], v[7]);
                *(u32x4*)p = pk;
            }
    }
};
struct EpiResid {
    static constexpr bool PERM = false, AFTER_DRAIN = false;
    float* X; const float* gate; float coef; const float2* stats; const float* lng; const float* lnb;
    __device__ __forceinline__ void operator()(const f32x4 (&acc)[2][2][4][2], const Unit& u, int wr, int wc, int fr, int fq) const {
        const int bidx = u.pm < 256 ? (u.pm >> 4) : 16 + ((u.pm - 256) >> 3);
        const int row0 = u.pm * BM + wr * 64 + fr, col0 = u.pn * BM + wc * 32 + 4 * fq;
        const float* gp = gate + (size_t)bidx * 9216 + col0;
        float mu[2][4], rs[2][4];
#pragma unroll
        for (int ai = 0; ai < 2; ++ai)
#pragma unroll
            for (int m = 0; m < 4; ++m) {
                mu[ai][m] = 0.f; rs[ai][m] = 1.f;
                if (lng) { const float2 st = stats[row0 + ai * HALF + m * 16]; mu[ai][m] = st.x; rs[ai][m] = st.y; }
            }
#pragma unroll
        for (int bj = 0; bj < 2; ++bj)
#pragma unroll
            for (int n = 0; n < 2; ++n) {
                const int co = bj * HALF + n * 16;
                const f32x4 gt = (*(const f32x4*)(gp + co) + 1.0f) * coef;
                f32x4 gg = {1.f, 1.f, 1.f, 1.f}, be = {0.f, 0.f, 0.f, 0.f};
                if (lng) { gg = *(const f32x4*)(lng + col0 + co); be = *(const f32x4*)(lnb + col0 + co); }
#pragma unroll
                for (int ai = 0; ai < 2; ++ai)
#pragma unroll
                    for (int m = 0; m < 4; ++m) {
                        float* ptr = X + (size_t)(row0 + ai * HALF + m * 16) * 1024 + col0 + co;
                        const f32x4 xv = *(const f32x4*)ptr;
                        const f32x4 xl = (xv - mu[ai][m]) * rs[ai][m] * gg + be;
                        *(f32x4*)ptr = xl * 1.681792830507429f + gt * acc[ai][bj][m][n];
                    }
            }
    }
};
struct EpiStore {
    static constexpr bool PERM = true, AFTER_DRAIN = false;
    bf16_t* O; size_t ldc;
    __device__ __forceinline__ void operator()(const f32x4 (&acc)[2][2][4][2], const Unit& u, int wr, int wc, int fr, int fq) const {
        const int row0 = u.pm * BM + wr * 64 + fr, col0 = u.pn * BM + wc * 32 + 8 * fq;
#pragma unroll
        for (int ai = 0; ai < 2; ++ai)
#pragma unroll
            for (int m = 0; m < 4; ++m) { bf16_t* p = O + (size_t)(row0 + ai * HALF + m * 16) * ldc + col0;
#pragma unroll
                for (int bj = 0; bj < 2; ++bj) { const f32x4 v0 = acc[ai][bj][m][0], v1 = acc[ai][bj][m][1];
                    u32x4 pk; pk[0] = cvt_pk_bf16(v0[0], v0[1]); pk[1] = cvt_pk_bf16(v0[2], v0[3]); pk[2] = cvt_pk_bf16(v1[0], v1[1]); pk[3] = cvt_pk_bf16(v1[2], v1[3]);
                    *(u32x4*)(p + bj * HALF) = pk; } }
    }
};

struct EpiAny {
    static constexpr bool AFTER_DRAIN = false;
    int mode; bool perm; bf16_t* O; size_t ldc; float* X; const float* gate; float coef; const float2* stats; const float* lng; const float* lnb;
    __device__ __forceinline__ void operator()(const f32x4 (&acc)[2][2][4][2], const Unit& u, int wr, int wc, int fr, int fq) const {
        if (mode == 0) { EpiSwiGLU e{O}; e(acc, u, wr, wc, fr, fq); }
        else if (mode == 1) { EpiResid e{X, gate, coef, stats, lng, lnb}; e(acc, u, wr, wc, fr, fq); }
        else { EpiStore e{O, ldc}; e(acc, u, wr, wc, fr, fq); }
    }
};
template <class Epi, class Sched, bool STAMP = false>
__device__ __forceinline__ void gemm_phase(PG8_LAS unsigned char* lds, const Gemm g, const Sched& S, const Epi& E, unsigned long long* stamps) {
    const int tid = ltid(), wid = __builtin_amdgcn_readfirstlane(tid >> 6), lane = tid & 63, wr = wid >> 2, wc = wid & 3, fr = lane & 15, fq = lane >> 4;
    const int K = g.K, nt = K / BK;
    int ts_lo = 0, ts_hi = 0, nts = 0; const unsigned long long rt_entry = STAMP ? (unsigned long long)wall_clock64() : 0ull;
#define PG8_STAMP() do { if (STAMP && wid == 0 && nts < 64) { const unsigned long long _c = (unsigned long long)clock64(); \
        ts_lo = (lane == nts) ? (int)(unsigned)_c : ts_lo; ts_hi = (lane == nts) ? (int)(unsigned)(_c >> 32) : ts_hi; ++nts; } } while (0)
    PG8_STAMP();
    unsigned voffA[2], voffB[2];
#pragma unroll
    for (int i = 0; i < 2; ++i) { int R, C; stage_rc(tid * 16 + i * 8192, R, C); const int Rb = E.perm ? ((R & ~31) + perm32(R & 31)) : R;
        voffA[i] = (unsigned)(R * K + C) * 2u; voffB[i] = (unsigned)(Rb * K + C) * 2u; }
    const size_t kstep = (size_t)(BK * 2);
    const size_t hstep = (size_t)HALF * K * 2;
    const size_t tstep = 2 * hstep;
    const unsigned ldsw = (unsigned)wid * 1024u;
    const int aoff = lds_byte(wr * 64 + fr, fq * 8), boff = lds_byte(wc * 32 + fr, fq * 8);
#define PG8_SA(b, h) (((b) * 2 + (h)) * HTB)
#define PG8_SB(b, h) ((4 + (b) * 2 + (h)) * HTB)
#define PG8_STAGE(bufoff, gbase, voff) do { _Pragma("unroll") for (int _i = 0; _i < 2; ++_i) \
        __builtin_amdgcn_global_load_lds((const unsigned*)((const char*)(gbase) + (voff)[_i]), (PG8_LAS unsigned*)(lds + (bufoff) + ldsw + _i * 8192), 16, 0, 0); } while (0)
#define PG8_LDA(dst, b, h) do { _Pragma("unroll") for (int m = 0; m < 4; ++m) _Pragma("unroll") for (int k = 0; k < 2; ++k) dst[m][k] = *(const PG8_LAS bf16x8*)(lds + PG8_SA(b, h) + aoff + m * 2048 + k * 1024); } while (0)
#define PG8_LDB(dst, b, h) do { _Pragma("unroll") for (int n = 0; n < 2; ++n) _Pragma("unroll") for (int k = 0; k < 2; ++k) dst[n][k] = *(const PG8_LAS bf16x8*)(lds + PG8_SB(b, h) + boff + n * 2048 + k * 1024); } while (0)
#define PG8_MMA(ai, bj, At, Bt) do { __builtin_amdgcn_s_setprio(1); _Pragma("unroll") for (int m = 0; m < 4; ++m) _Pragma("unroll") for (int n = 0; n < 2; ++n) _Pragma("unroll") for (int k = 0; k < 2; ++k) \
        acc[ai][bj][m][n] = __builtin_amdgcn_mfma_f32_16x16x32_bf16(Bt[n][k], At[m][k], acc[ai][bj][m][n], 0, 0, 0); __builtin_amdgcn_s_setprio(0); } while (0)
#define PG8_WAIT_V(n) asm volatile("s_waitcnt vmcnt(" #n ")" ::: "memory")
#define PG8_WAIT_L(n) asm volatile("s_waitcnt lgkmcnt(" #n ")" ::: "memory")
#define PG8_BAR __builtin_amdgcn_s_barrier()
#define PG8_SCHED __builtin_amdgcn_sched_barrier(0)
    Unit cur, nxt; int ui = 0;
    if (!S.next(0, cur)) return;
    f32x4 acc[2][2][4][2];
#pragma unroll
    for (int a = 0; a < 2; ++a)
#pragma unroll
        for (int b = 0; b < 2; ++b)
#pragma unroll
            for (int m = 0; m < 4; ++m)
#pragma unroll
                for (int n = 0; n < 2; ++n) acc[a][b][m][n] = (f32x4){0.f, 0.f, 0.f, 0.f};
    bf16x8 At[4][2], B0[2][2], B1[2][2];
    const char* cA = (const char*)g.A + (size_t)cur.pm * tstep; const char* cB = (const char*)g.Bt + (size_t)cur.pn * tstep;
    S.a_ready(cur);
    PG8_STAGE(PG8_SB(0, 0), cB, voffB); PG8_STAGE(PG8_SA(0, 0), cA, voffA); PG8_STAGE(PG8_SB(0, 1), cB + hstep, voffB); PG8_STAGE(PG8_SA(0, 1), cA + hstep, voffA);
    if (wr == 1) PG8_BAR;
    PG8_WAIT_V(4); PG8_BAR;
    PG8_STAGE(PG8_SB(1, 0), cB + kstep, voffB); PG8_STAGE(PG8_SA(1, 0), cA + kstep, voffA); PG8_STAGE(PG8_SB(1, 1), cB + hstep + kstep, voffB);
    PG8_WAIT_V(6); PG8_BAR;
    PG8_STAMP();
    for (;;) {
        const bool has_next = S.next(ui + 1, nxt);
        const char* nA = has_next ? (const char*)g.A + (size_t)nxt.pm * tstep : cA; const char* nB = has_next ? (const char*)g.Bt + (size_t)nxt.pn * tstep : cB;
        for (int t = 0; t < nt; t += 2) {
            const bool last = (t == nt - 2);
            const char* a1 = cA + (size_t)(t + 1) * kstep;
            const char* a2 = last ? nA : cA + (size_t)(t + 2) * kstep; const char* b2 = last ? nB : cB + (size_t)(t + 2) * kstep;
            const char* a3 = a2 + kstep; const char* b3 = b2 + kstep;
            if (last && has_next) S.a_ready(nxt);
            PG8_LDB(B0, 0, 0); PG8_SCHED; PG8_LDA(At, 0, 0); PG8_STAGE(PG8_SA(1, 1), a1 + hstep, voffA);
            PG8_WAIT_L(8); PG8_BAR; PG8_WAIT_L(0); PG8_MMA(0, 0, At, B0); PG8_BAR; PG8_SCHED;
            PG8_LDB(B1, 0, 1); PG8_STAGE(PG8_SB(0, 0), b2, voffB);
            PG8_BAR; PG8_WAIT_L(0); PG8_MMA(0, 1, At, B1); PG8_BAR;
            PG8_LDA(At, 0, 1); PG8_STAGE(PG8_SA(0, 0), a2, voffA);
            PG8_BAR; PG8_WAIT_L(0); PG8_MMA(1, 0, At, B0); PG8_BAR; PG8_SCHED;
            PG8_STAGE(PG8_SB(0, 1), b2 + hstep, voffB);
            PG8_WAIT_V(6); PG8_BAR; PG8_MMA(1, 1, At, B1); PG8_BAR;
            PG8_LDB(B0, 1, 0); PG8_SCHED; PG8_LDA(At, 1, 0); PG8_STAGE(PG8_SA(0, 1), a2 + hstep, voffA);
            PG8_WAIT_L(8); PG8_BAR; PG8_WAIT_L(0); PG8_MMA(0, 0, At, B0); PG8_BAR; PG8_SCHED;
            PG8_LDB(B1, 1, 1); PG8_STAGE(PG8_SB(1, 0), b3, voffB);
            PG8_BAR; PG8_WAIT_L(0); PG8_MMA(0, 1, At, B1); PG8_BAR;
            PG8_LDA(At, 1, 1); PG8_STAGE(PG8_SA(1, 0), a3, voffA);
            PG8_BAR; PG8_WAIT_L(0); PG8_MMA(1, 0, At, B0); PG8_BAR; PG8_SCHED;
            PG8_STAGE(PG8_SB(1, 1), b3 + hstep, voffB);
            PG8_WAIT_V(6); PG8_BAR; PG8_MMA(1, 1, At, B1); PG8_BAR;
        }
        PG8_STAMP();
        if constexpr (!Epi::AFTER_DRAIN) { E(acc, cur, wr, wc, fr, fq); S.done(cur); }
        PG8_STAMP();
        if (!has_next) break;
#pragma unroll
        for (int a = 0; a < 2; ++a)
#pragma unroll
            for (int b = 0; b < 2; ++b)
#pragma unroll
                for (int m = 0; m < 4; ++m)
#pragma unroll
                    for (int n = 0; n < 2; ++n) acc[a][b][m][n] = (f32x4){0.f, 0.f, 0.f, 0.f};
        cur = nxt; cA = nA; cB = nB; ++ui;
    }
    PG8_WAIT_V(0);
    if (wr == 0) PG8_BAR;
    PG8_BAR;
    if constexpr (Epi::AFTER_DRAIN) { E.fused(acc, cur, wr, wc, fr, fq, lds, wid, lane); S.done(cur); }
    PG8_STAMP();
    if (STAMP && wid == 0) { stamps[lane] = lane < nts ? (((unsigned long long)(unsigned)ts_hi << 32) | (unsigned)ts_lo) : 0ull;
        if (lane == 62) stamps[62] = rt_entry; if (lane == 63) stamps[63] = (unsigned long long)wall_clock64(); }
#undef PG8_STAMP
#undef PG8_SA
#undef PG8_SB
#undef PG8_STAGE
#undef PG8_LDA
#undef PG8_LDB
#undef PG8_MMA
#undef PG8_WAIT_V
#undef PG8_WAIT_L
#undef PG8_BAR
#undef PG8_SCHED
}
}

typedef unsigned short bf16_t;
typedef short bf16x8 __attribute__((ext_vector_type(8)));
typedef float f32x4 __attribute__((ext_vector_type(4)));
typedef float f32x16 __attribute__((ext_vector_type(16)));
typedef unsigned u32x4 __attribute__((ext_vector_type(4)));
typedef unsigned u32x2 __attribute__((ext_vector_type(2)));

constexpr int MTOT = 98304, NLAYER = 4;
constexpr size_t WL_ELEMS = 20971520;
constexpr size_t WO_WI1 = 0, WO_WO1 = 5767168, WO_WI2 = 8650752, WO_WO2 = 14417920, WO_WINA = 17301504, WO_WINB = 18087936, WO_WOUT = 19922944;
constexpr size_t OFF_W = 0;
constexpr size_t OFF_MOD = 167772160;
constexpr size_t OFF_ROPE = OFF_MOD + 4718592;
constexpr size_t OFF_H3 = OFF_ROPE + 262144;
constexpr size_t OFF_KF = OFF_H3 + 6291456;
constexpr int KS4 = 4104, KS2 = 2056;
constexpr size_t KF_LAYER = (size_t)512 * (KS4 + KS2);
constexpr size_t OFF_H = OFF_KF + 4 * KF_LAYER * 8;
constexpr size_t OFF_ACT = OFF_H + (size_t)MTOT * 1024 * 2;
constexpr size_t OFF_ZA = OFF_ACT;
constexpr size_t OFF_ZT = OFF_ACT + (size_t)MTOT * 768 * 2;
constexpr size_t OFF_STATS = OFF_ACT + (size_t)MTOT * 2816 * 2;
constexpr size_t OFF_BAR = OFF_STATS + (size_t)MTOT * 8;
constexpr size_t BAR_BYTES = 16384;
constexpr size_t WS_NEED = OFF_BAR + BAR_BYTES;
static_assert(OFF_ZT + (size_t)1792 * MTOT * 2 <= OFF_STATS, "mixer overlay fits");
constexpr int LDS_BYTES = 137216;
constexpr int NPHASE = 2 + 11 * NLAYER;
#ifndef EN_GEMM
#define EN_GEMM 1
#endif
#ifndef EN_LN
#define EN_LN 1
#endif
#ifndef EN_ATT
#define EN_ATT 1
#endif
#ifndef EN_HY
#define EN_HY 1
#endif
#ifndef EN_RMS
#define EN_RMS 1
#endif
#ifndef EN_P0
#define EN_P0 1
#endif
#ifndef EN_P1
#define EN_P1 1
#endif

struct Params { const float* in[28]; float* X; unsigned char* ws; int ph_lo, ph_hi; };
#define PIN (p.in + zl)
__device__ __forceinline__ int launder0() { int z = 0; asm volatile("" : "+s"(z)); return z; }

__device__ __forceinline__ float bf_lo(unsigned u) { return __uint_as_float(u << 16); }
__device__ __forceinline__ float bf_hi(unsigned u) { return __uint_as_float(u & 0xffff0000u); }
__device__ __forceinline__ float bf2f(bf16_t b) { return __uint_as_float(((unsigned)b) << 16); }
__device__ __forceinline__ unsigned pk2(float lo, float hi) { return pg8::cvt_pk_bf16(lo, hi); }
__device__ __forceinline__ float sin_rev(float r) { return __builtin_amdgcn_sinf(r); }
__device__ __forceinline__ float cos_rev(float r) { return __builtin_amdgcn_cosf(r); }
__device__ __forceinline__ float sin_rad(float x) { float r = x * 0.15915494309189535f; r -= rintf(r); return __builtin_amdgcn_sinf(r); }
__device__ __forceinline__ float cos_rad(float x) { float r = x * 0.15915494309189535f; r -= rintf(r); return __builtin_amdgcn_cosf(r); }
__device__ __forceinline__ float wave_sum(float v) {
#pragma unroll
    for (int o = 1; o < 64; o <<= 1) v += __shfl_xor(v, o);
    return v;
}
__device__ __forceinline__ int row_bidx(int row) { return row < 65536 ? (row >> 12) : 16 + ((row - 65536) >> 11); }

__device__ __forceinline__ void cvt_tile(const float* __restrict__ src, int ldN, int k0, int c0, bf16_t* __restrict__ dst, int ldK, int n0, bool zero, float* tile) {
    const int tid = ltid();
    {
        const int r = tid >> 4, c4 = (tid & 15) * 4;
#pragma unroll
        for (int ps = 0; ps < 2; ++ps) {
            const int k = r + 32 * ps;
            f32x4 v = {0.f, 0.f, 0.f, 0.f};
            if (!zero) v = *(const f32x4*)(src + (size_t)(k0 + k) * ldN + c0 + c4);
            tile[k * 65 + c4 + 0] = v[0]; tile[k * 65 + c4 + 1] = v[1]; tile[k * 65 + c4 + 2] = v[2]; tile[k * 65 + c4 + 3] = v[3];
        }
    }
    __syncthreads();
    {
        const int n = tid >> 3, kq = tid & 7;
        float f[8];
#pragma unroll
        for (int j = 0; j < 8; ++j) f[j] = tile[(kq * 8 + j) * 65 + n];
        u32x4 pk; pk[0] = pk2(f[0], f[1]); pk[1] = pk2(f[2], f[3]); pk[2] = pk2(f[4], f[5]); pk[3] = pk2(f[6], f[7]);
        *(u32x4*)(dst + (size_t)(n0 + n) * ldK + k0 + kq * 8) = pk;
    }
    __syncthreads();
}

__device__ __forceinline__ void phase0a(const Params& p, unsigned char* smem) {
    const int zl = launder0(); unsigned char* const wsp = lptr(p.ws); float* const xp = lptr(p.X); (void)xp;
    const int tid = ltid();
    float* tile = (float*)smem;
    for (int t = blockIdx.x; t < 20480; t += gridDim.x) {
        const int l = t / 5120, r = t % 5120;
        bf16_t* wl = (bf16_t*)(wsp + OFF_W) + (size_t)l * WL_ELEMS;
        const float* src; int ldN, k0, c0, ldK, n0; bf16_t* dst; bool zero = false;
        if (r < 2816) {
            const int which = r / 1408, rr = r % 1408, nt = rr / 16, kt = rr % 16;
            src = PIN[which ? 8 : 6] + (size_t)l * 1024 * 5632; ldN = 5632; k0 = kt * 64; n0 = nt * 64;
            const int tt = n0 >> 8, within = n0 & 255;
            c0 = within < 128 ? 128 * tt + within : 2816 + 128 * tt + (within - 128);
            dst = wl + (which ? WO_WI2 : WO_WI1); ldK = 1024;
        } else if (r < 4224) {
            const int q = r - 2816, which = q / 704, rr = q % 704, nt = rr / 44, kt = rr % 44;
            src = PIN[which ? 9 : 7] + (size_t)l * 2816 * 1024; ldN = 1024; k0 = kt * 64; n0 = nt * 64; c0 = n0;
            dst = wl + (which ? WO_WO2 : WO_WO1); ldK = 2816;
        } else if (r < 4416) {
            const int q = r - 4224, nt = q / 16, kt = q % 16;
            src = PIN[12] + (size_t)l * 1024 * 2304; ldN = 2304; k0 = kt * 64; n0 = nt * 64; c0 = n0;
            dst = wl + WO_WINA; ldK = 1024;
        } else if (r < 4864) {
            const int q = r - 4416, nt = q / 16, kt = q % 16;
            src = PIN[12] + (size_t)l * 1024 * 2304; ldN = 2304; k0 = kt * 64; n0 = nt * 64;
            if (n0 < 1536) c0 = 768 + n0; else if (n0 < 1664) c0 = 640 + (n0 - 1536); else { c0 = 0; zero = true; }
            dst = wl + WO_WINB; ldK = 1024;
        } else {
            const int q = r - 4864, nt = q / 16, kt = q % 16;
            src = PIN[13] + (size_t)l * 1024 * 1024; ldN = 1024; k0 = kt * 64; n0 = nt * 64; c0 = n0;
            dst = wl + WO_WOUT; ldK = 1024;
        }
        cvt_tile(src, ldN, k0, c0, dst, ldK, n0, zero, tile);
    }
    {
        float* sc = (float*)smem;
        float* MOD = (float*)(wsp + OFF_MOD);
        for (int u = blockIdx.x; u < 288; u += gridDim.x) {
            const int l = u / 72, cch = u % 72;
            for (int idx = tid; idx < 32768; idx += 512) {
                const int b = idx >> 10, k = idx & 1023;
                const float c = b < 16 ? PIN[2][b * 1024 + k] : PIN[3][(b - 16) * 1024 + k];
                sc[k * 32 + b] = c / (1.0f + __expf(-c));
            }
            __syncthreads();
            const int cl = tid & 127, ks = tid >> 7, col = cch * 128 + cl;
            float acc[32];
#pragma unroll
            for (int b = 0; b < 32; ++b) acc[b] = 0.f;
            const float* wp = PIN[4] + ((size_t)l * 1024 + ks * 256) * 9216 + col;
            for (int k = 0; k < 256; ++k) {
                const float w = wp[(size_t)k * 9216];
                const f32x4* sp = (const f32x4*)(sc + (ks * 256 + k) * 32);
#pragma unroll
                for (int b4 = 0; b4 < 8; ++b4) { const f32x4 s = sp[b4]; acc[b4 * 4 + 0] += s[0] * w; acc[b4 * 4 + 1] += s[1] * w; acc[b4 * 4 + 2] += s[2] * w; acc[b4 * 4 + 3] += s[3] * w; }
            }
            __syncthreads();
            float* part = (float*)smem;
#pragma unroll
            for (int b = 0; b < 32; ++b) part[(ks * 32 + b) * 128 + cl] = acc[b];
            __syncthreads();
            for (int idx = tid; idx < 4096; idx += 512) {
                const int b = idx >> 7, c2 = idx & 127, cc = cch * 128 + c2;
                const float s = part[(0 * 32 + b) * 128 + c2] + part[(1 * 32 + b) * 128 + c2] + part[(2 * 32 + b) * 128 + c2] + part[(3 * 32 + b) * 128 + c2];
                MOD[((size_t)l * 32 + b) * 9216 + cc] = s + PIN[5][l * 9216 + cc];
            }
            __syncthreads();
        }
    }
    {
        float* zb = (float*)smem; float* ha = zb + 8 * 40; float* hb = ha + 8 * 64;
        float* H3 = (float*)(wsp + OFF_H3);
        for (int u = blockIdx.x; u < 384; u += gridDim.x) {
            const int l = u / 96, v = u % 96;
            const int Lsel = v >= 64, chunk = Lsel ? v - 64 : v, L = Lsel ? 2048 : 4096;
            const int lr = tid >> 6, j = tid & 63;
            const float fr = PIN[25][l * 64 + j];
            for (int it = 0; it < 8; ++it) {
                const int pos = chunk * 64 + it * 8 + lr;
                if (j < 33) {
                    const float tt = (float)pos / (float)(L - 1), w = (6.2831855f * (float)pos) / (float)L;
                    float val;
                    if (j == 0) val = tt;
                    else if (j <= 16) { const float fb = 1e-4f + (float)(j - 1) * 0.99999333f; val = cos_rad(fb * w); }
                    else { const float fb = 1e-4f + (float)(j - 17) * 0.99999333f; val = -sin_rad(fb * w); }
                    zb[lr * 40 + j] = val;
                }
                __syncthreads();
                float a = PIN[19][l * 64 + j];
                for (int i = 0; i < 33; ++i) a += zb[lr * 40 + i] * PIN[18][((size_t)l * 33 + i) * 64 + j];
                ha[lr * 64 + j] = sin_rad(fr * a);
                __syncthreads();
                a = PIN[21][l * 64 + j];
                for (int i = 0; i < 64; ++i) a += ha[lr * 64 + i] * PIN[20][((size_t)l * 64 + i) * 64 + j];
                hb[lr * 64 + j] = sin_rad(fr * a);
                __syncthreads();
                a = PIN[23][l * 64 + j];
                for (int i = 0; i < 64; ++i) a += hb[lr * 64 + i] * PIN[22][((size_t)l * 64 + i) * 64 + j];
                H3[((size_t)l * 6144 + (Lsel ? 4096 : 0) + pos) * 64 + j] = sin_rad(fr * a);
                __syncthreads();
            }
        }
    }
    {
        const double INV[8] = {1.0, 0.19392274474868576, 0.03760603093086393, 0.007292664737217109, 0.001414213562373095, 0.0002742481756762073, 5.318295896944988e-05, 1.031338537721246e-05};
        float2* rope = (float2*)(wsp + OFF_ROPE);
        for (int idx = blockIdx.x * 512 + tid; idx < 32768; idx += gridDim.x * 512) {
            const int pos = idx >> 3, i = idx & 7;
            double inv = INV[0];
#pragma unroll
            for (int q = 1; q < 8; ++q) inv = (i == q) ? INV[q] : inv;
            double r = (double)pos * inv * 0.15915494309189535; r -= rint(r);
            const float rf = (float)r;
            rope[idx] = make_float2(cos_rev(rf), sin_rev(rf));
        }
    }
}

__device__ __forceinline__ int PIX(int i) { return i + (i >> 5); }
constexpr int FFT_LDS_BYTES = (8192 + 256) * 8;
__device__ __forceinline__ float2 cmul(float2 a, float2 b) { return make_float2(a.x * b.x - a.y * b.y, a.x * b.y + a.y * b.x); }
__device__ __forceinline__ float2 cmulc(float2 a, float2 b) { return make_float2(a.x * b.x + a.y * b.y, a.y * b.x - a.x * b.y); }
#define ROOT16X(k) ((k) == 0 ? 1.0f : (k) == 1 ? 0.92387953251f : (k) == 2 ? 0.70710678119f : (k) == 3 ? 0.38268343237f : (k) == 4 ? 0.0f : (k) == 5 ? -0.38268343237f : (k) == 6 ? -0.70710678119f : -0.92387953251f)
#define ROOT16Y(k) ((k) == 0 ? 0.0f : (k) == 1 ? -0.38268343237f : (k) == 2 ? -0.70710678119f : (k) == 3 ? -0.92387953251f : (k) == 4 ? -1.0f : (k) == 5 ? -0.92387953251f : (k) == 6 ? -0.70710678119f : -0.38268343237f)
constexpr int FFT_BUF_STRIDE = 8192 + 256;
template <int LOGN, int S, int R, bool INV, int NB, bool HALF = false>
__device__ __forceinline__ void fft_pass(float2* buf, int tid) {
    constexpr int RR = 1 << R, N = 1 << LOGN, lgD = LOGN - S - R, D = 1 << lgD, ngroups = N >> R;
    static_assert(D >= 32 || D == 16 || D == 2 || D == 1, "padded-index shortcut");
    for (int gidx = tid; gidx < ngroups; gidx += 512) {
        const int lo = gidx & (D - 1), hi = gidx >> lgD, base = (hi << (LOGN - S)) + lo, pb = PIX(base);
        const float fr = (float)lo * (1.0f / (float)(D << R));
        float2 wq[R];
        wq[0] = make_float2(cos_rev(fr), -sin_rev(fr));
#pragma unroll
        for (int q = 1; q < R; ++q) wq[q] = cmul(wq[q - 1], wq[q - 1]);
        float2 tw[RR];
#pragma unroll
        for (int q = 0; q < R; ++q) {
            const int h = 1 << (R - 1 - q);
#pragma unroll
            for (int k = 0; k < h; ++k) { const int ri = k << (4 - R + q); tw[RR - 2 * h + k] = cmul(wq[q], make_float2(ROOT16X(ri), ROOT16Y(ri))); }
        }
#pragma unroll
        for (int nb = 0; nb < NB; ++nb) {
            float2* bb = buf + nb * FFT_BUF_STRIDE;
            float2 v[RR];
#pragma unroll
            for (int m = 0; m < RR; ++m) { if (HALF && !INV && m >= RR / 2) v[m] = make_float2(0.f, 0.f); else v[m] = bb[pb + m * D + ((m * D) >> 5)]; }
#pragma unroll
            for (int qq = 0; qq < R; ++qq) {
                const int q = INV ? (R - 1 - qq) : qq;
                const int h = 1 << (R - 1 - q);
#pragma unroll
                for (int k = 0; k < h; ++k) {
                    const float2 t_w = tw[RR - 2 * h + k];
#pragma unroll
                    for (int blk = 0; blk < RR; blk += 2 * h) {
                        const int m0 = blk + k, m1 = m0 + h;
                        const float2 a = v[m0], b = v[m1];
                        if (!INV && HALF && q == 0) { v[m1] = cmul(a, t_w); }
                        else if (!INV) { v[m0] = make_float2(a.x + b.x, a.y + b.y); v[m1] = cmul(make_float2(a.x - b.x, a.y - b.y), t_w); }
                        else { const float2 t = cmulc(b, t_w); v[m0] = make_float2(a.x + t.x, a.y + t.y); v[m1] = make_float2(a.x - t.x, a.y - t.y); }
                    }
                }
            }
#pragma unroll
            for (int m = 0; m < RR; ++m) { if (HALF && INV && m >= RR / 2) continue; bb[pb + m * D + ((m * D) >> 5)] = v[m]; }
        }
    }
    __syncthreads();
}
template <int LOGN, int NB, bool HALF = false> __device__ __forceinline__ void fft_fwd(float2* buf, int tid) {
    fft_pass<LOGN, 0, 4, false, NB, HALF>(buf, tid); fft_pass<LOGN, 4, 4, false, NB>(buf, tid); fft_pass<LOGN, 8, 4, false, NB>(buf, tid);
    if constexpr (LOGN == 13) fft_pass<LOGN, 12, 1, false, NB>(buf, tid);
}
template <int LOGN, int NB, bool HALF = false> __device__ __forceinline__ void fft_inv(float2* buf, int tid) {
    if constexpr (LOGN == 13) fft_pass<LOGN, 12, 1, true, NB>(buf, tid);
    fft_pass<LOGN, 8, 4, true, NB>(buf, tid); fft_pass<LOGN, 4, 4, true, NB>(buf, tid); fft_pass<LOGN, 0, 4, true, NB, HALF>(buf, tid);
}

template <int LOGN>
__device__ __forceinline__ void filt_unit(const Params& p, int l, int cp, unsigned char* smem, int zl, unsigned char* wsp) {
    const int tid = ltid();
    float2* buf = (float2*)smem; float* w4s = (float*)(smem + 69632);
    const float* H3 = (const float*)(wsp + OFF_H3);
    float2* KF = (float2*)(wsp + OFF_KF);
    {
        constexpr int Lsel = (LOGN == 12), L = 1 << (LOGN - 1), logN = LOGN, N = 2 * L;
        if (tid < 256) { const int i = tid >> 2, q = tid & 3; w4s[tid] = PIN[24][((size_t)l * 64 + i) * 1024 + (q >> 1) * 512 + 2 * cp + (q & 1)]; }
        const float d00 = fabsf(PIN[26][(l * 2 + 0) * 512 + 2 * cp]), d01 = fabsf(PIN[26][(l * 2 + 0) * 512 + 2 * cp + 1]);
        const float d10 = fabsf(PIN[26][(l * 2 + 1) * 512 + 2 * cp]), d11 = fabsf(PIN[26][(l * 2 + 1) * 512 + 2 * cp + 1]);
        __syncthreads();
#pragma nounroll
        for (int pos = tid; pos < L; pos += 512) {
            const f32x4* hrow = (const f32x4*)(H3 + ((size_t)l * 6144 + (Lsel ? 4096 : 0) + pos) * 64);
            float a0 = 0.f, a1 = 0.f, a2 = 0.f, a3 = 0.f;
#pragma unroll
            for (int i4 = 0; i4 < 16; ++i4) {
                const f32x4 h = hrow[i4];
#pragma unroll
                for (int e = 0; e < 4; ++e) { const f32x4 wv = *(const f32x4*)(w4s + (i4 * 4 + e) * 4); a0 += h[e] * wv[0]; a1 += h[e] * wv[1]; a2 += h[e] * wv[2]; a3 += h[e] * wv[3]; }
            }
            const float tt = (float)pos / (float)(L - 1);
            const float hf1 = a0 * __expf(-tt * d00), hf2 = a1 * __expf(-tt * d01), hb1 = a2 * __expf(-tt * d10), hb2 = a3 * __expf(-tt * d11);
            if (pos == 0) { buf[0] = make_float2(hf1 + hb1, hf2 + hb2); buf[PIX(L)] = make_float2(0.f, 0.f); }
            else { buf[PIX(pos)] = make_float2(hf1, hf2); buf[PIX(N - pos)] = make_float2(hb1, hb2); }
        }
        __syncthreads();
        fft_fwd<LOGN, 1>(buf, tid);
        const float sc = 0.25f / (float)N;
        float2* K1 = KF + (size_t)l * KF_LAYER + (Lsel ? (size_t)512 * KS4 + (size_t)(2 * cp) * KS2 : (size_t)(2 * cp) * KS4);
        float2* K2 = K1 + (Lsel ? KS2 : KS4);
#pragma nounroll
        for (int k = tid; k <= L; k += 512) {
            const int pa = (int)(__brev((unsigned)k) >> (32 - logN)), pb = (int)(__brev((unsigned)((N - k) & (N - 1))) >> (32 - logN));
            const float2 a = buf[PIX(pa)], b = buf[PIX(pb)];
            K1[k] = make_float2((a.x + b.x) * sc, (a.y - b.y) * sc);
            K2[k] = make_float2((a.y + b.y) * sc, -(a.x - b.x) * sc);
        }
        __syncthreads();
    }
}

__device__ __forceinline__ void phase0b(const Params& p, unsigned char* smem) {
    const int zl = launder0(); unsigned char* const wsp = lptr(p.ws); float* const xp = lptr(p.X); (void)xp;
    const int tid = ltid(), lane = tid & 63, w = tid >> 6;
    float2* buf = (float2*)smem; float* w4s = (float*)(smem + 69632);
    const float* H3 = (const float*)(wsp + OFF_H3);
    float2* KF = (float2*)(wsp + OFF_KF);
    for (int v = blockIdx.x; v < 2048; v += gridDim.x) {
        const int l = v >> 9, ww = v & 511, cp = ww & 255;
        if (ww >> 8) filt_unit<12>(p, l, cp, smem, zl, wsp); else filt_unit<13>(p, l, cp, smem, zl, wsp);
    }
    {
        const float* MOD = (const float*)(wsp + OFF_MOD);
        bf16_t* H = (bf16_t*)(wsp + OFF_H);
        for (int row = blockIdx.x * 8 + w; row < MTOT; row += gridDim.x * 8) {
            const float* src = row < 65536 ? PIN[0] + (size_t)row * 1024 : PIN[1] + (size_t)(row - 65536) * 1024;
            const float* md = MOD + (size_t)row_bidx(row) * 9216;
#pragma unroll
            for (int i = 0; i < 4; ++i) {
                const int col = i * 256 + lane * 4;
                const f32x4 v = *(const f32x4*)(src + col), sh = *(const f32x4*)(md + col), scl = *(const f32x4*)(md + 1024 + col);
                *(f32x4*)(xp + (size_t)row * 1024 + col) = v;
                const f32x4 h = v * (scl + 1.0f) + sh;
                u32x2 pk; pk[0] = pk2(h[0], h[1]); pk[1] = pk2(h[2], h[3]);
                *(u32x2*)(H + (size_t)row * 1024 + col) = pk;
            }
        }
    }
}

__device__ __forceinline__ void lnmod_phase(unsigned char* wsp, float* xp, const float* __restrict__ g, const float* __restrict__ bb, const float* __restrict__ modbase, bool write_x) {
    const int tid = ltid(), lane = tid & 63, w = tid >> 6;
    bf16_t* H = (bf16_t*)(wsp + OFF_H);
    float2* stats = (float2*)(wsp + OFF_STATS);
    constexpr int NR = 4;
    for (int rp = blockIdx.x * 8 + w; rp < MTOT / NR; rp += gridDim.x * 8) {
        const int row = rp * NR;
        float* xr = xp + (size_t)row * 1024;
        f32x4 v[NR][4];
#pragma unroll
        for (int r2 = 0; r2 < NR; ++r2)
#pragma unroll
            for (int i = 0; i < 4; ++i) v[r2][i] = *(const f32x4*)(xr + r2 * 1024 + i * 256 + lane * 4);
        float mean[NR], rstd[NR];
#pragma unroll
        for (int r2 = 0; r2 < NR; ++r2) {
            float s = 0.f;
#pragma unroll
            for (int i = 0; i < 4; ++i) s += v[r2][i][0] + v[r2][i][1] + v[r2][i][2] + v[r2][i][3];
            mean[r2] = s;
        }
#pragma unroll
        for (int o = 1; o < 64; o <<= 1)
#pragma unroll
            for (int r2 = 0; r2 < NR; ++r2) mean[r2] += __shfl_xor(mean[r2], o);
#pragma unroll
        for (int r2 = 0; r2 < NR; ++r2) {
            mean[r2] *= (1.0f / 1024.0f);
            float q = 0.f;
#pragma unroll
            for (int i = 0; i < 4; ++i) { const f32x4 d = v[r2][i] - mean[r2]; q += d[0] * d[0] + d[1] * d[1] + d[2] * d[2] + d[3] * d[3]; }
            rstd[r2] = q;
        }
#pragma unroll
        for (int o = 1; o < 64; o <<= 1)
#pragma unroll
            for (int r2 = 0; r2 < NR; ++r2) rstd[r2] += __shfl_xor(rstd[r2], o);
#pragma unroll
        for (int r2 = 0; r2 < NR; ++r2) {
            rstd[r2] = rsqrtf(rstd[r2] * (1.0f / 1024.0f) + 1e-5f);
            if (lane == 0) stats[row + r2] = make_float2(mean[r2], rstd[r2]);
        }
        const float* md = modbase ? modbase + (size_t)row_bidx(row) * 9216 : nullptr;
#pragma unroll
        for (int i = 0; i < 4; ++i) {
            const int col = i * 256 + lane * 4;
            const f32x4 gg = *(const f32x4*)(g + col), be = *(const f32x4*)(bb + col);
            f32x4 sh = {0.f, 0.f, 0.f, 0.f}, scl = {0.f, 0.f, 0.f, 0.f};
            if (md) { sh = *(const f32x4*)(md + col); scl = *(const f32x4*)(md + 1024 + col); }
#pragma unroll
            for (int r2 = 0; r2 < NR; ++r2) {
                const f32x4 xn = (v[r2][i] - mean[r2]) * rstd[r2] * gg + be;
                if (write_x) *(f32x4*)(xr + r2 * 1024 + col) = xn;
                if (md) {
                    const f32x4 h = xn * (scl + 1.0f) + sh;
                    u32x2 pk; pk[0] = pk2(h[0], h[1]); pk[1] = pk2(h[2], h[3]);
                    *(u32x2*)(H + (size_t)(row + r2) * 1024 + col) = pk;
                }
            }
        }
    }
}

__device__ __forceinline__ u32x4 rope_apply(u32x4 mine, u32x4 other, const float2* __restrict__ tab, int second) {
    u32x4 out;
#pragma unroll
    for (int q = 0; q < 4; ++q) {
        const f32x4 cs = *(const f32x4*)(tab + 2 * q);
        const float m0 = bf_lo(mine[q]), m1 = bf_hi(mine[q]), o0 = bf_lo(other[q]), o1 = bf_hi(other[q]);
        const float r0 = second ? m0 * cs[0] + o0 * cs[1] : m0 * cs[0] - o0 * cs[1];
        const float r1 = second ? m1 * cs[2] + o1 * cs[3] : m1 * cs[2] - o1 * cs[3];
        out[q] = pk2(r0, r1);
    }
    return out;
}

__device__ __forceinline__ void attn_unit(const Params& p, int l, int ua, unsigned char* smem) {
    const int zl = launder0(); unsigned char* const wsp = lptr(p.ws); float* const xp = lptr(p.X); (void)xp;
    const int tid = ltid(), lane = tid & 63, w = tid >> 6;
    const int qb = ua >> 1, g = ua & 1;
    int blk, nb;
    if (qb < 512) { blk = qb & 31; nb = 32; } else { blk = (qb - 512) & 15; nb = 16; }
    const int row0 = qb * 128, pos0 = blk * 128;
    const bool hasPrev = blk > 0, hasNext = blk < nb - 1;
    const bf16_t* ZA = (const bf16_t*)(wsp + OFF_ZA);
    const bf16_t* ZT = (const bf16_t*)(wsp + OFF_ZT);
    bf16_t* A2 = (bf16_t*)(wsp + OFF_H);
    const float2* rope = (const float2*)(wsp + OFF_ROPE);
    unsigned char* Ks = smem;
    unsigned char* Vs = smem + 55296;
#pragma unroll
    for (int i = 0; i < 6; ++i) {
        const int idx = tid + 512 * i, kb = idx >> 3, part = idx & 7, b3 = kb >> 7;
        const bool valid = (b3 == 1) || (b3 == 0 && hasPrev) || (b3 == 2 && hasNext);
        u32x4 v = {0u, 0u, 0u, 0u};
        if (valid) {
            const bf16_t* src = ZA + (size_t)(row0 - 128 + kb) * 768 + 512 + g * 64;
            v = *(const u32x4*)(src + part * 8);
            if (part < 2) { const u32x4 o = *(const u32x4*)(src + (part ^ 1) * 8); v = rope_apply(v, o, rope + (size_t)(pos0 - 128 + kb) * 8, part); }
        }
        *(u32x4*)(Ks + kb * 144 + part * 16) = v;
    }
#pragma unroll
    for (int i = 0; i < 6; ++i) {
        const int idx = tid + 512 * i, d = idx / 48, part = idx % 48, kb0 = part * 8, b3 = kb0 >> 7;
        const bool valid = (b3 == 1) || (b3 == 0 && hasPrev) || (b3 == 2 && hasNext);
        u32x4 v = {0u, 0u, 0u, 0u};
        if (valid) v = *(const u32x4*)(ZT + (size_t)(1536 + g * 64 + d) * MTOT + row0 - 128 + kb0);
        *(u32x4*)(Vs + d * 784 + part * 16) = v;
    }
    __syncthreads();
    const int hh = w >> 1, head = g * 4 + hh;
    const float sinkv = PIN[14][l * 8 + head];
    const int r = lane & 31, h = lane >> 5;
    for (int qt = 0; qt < 2; ++qt) {
        const int qi = (w & 1) * 2 + qt;
        const int qrow = row0 + 32 * qi + r, qpos = pos0 + 32 * qi + r;
        const bf16_t* qsrc = ZA + (size_t)qrow * 768 + head * 64;
        bf16x8 qf[4];
#pragma unroll
        for (int s = 0; s < 4; ++s) {
            u32x4 v = *(const u32x4*)(qsrc + 16 * s + 8 * h);
            if (s == 0) { const u32x4 o = *(const u32x4*)(qsrc + 8 * (1 - h)); v = rope_apply(v, o, rope + (size_t)qpos * 8, h); }
#pragma unroll
            for (int q = 0; q < 4; ++q) v[q] = pk2(bf_lo(v[q]) * 0.125f, bf_hi(v[q]) * 0.125f);
            qf[s] = __builtin_bit_cast(bf16x8, v);
        }
        float mrun = sinkv, lsum = 1.0f;
        f32x16 O[2];
#pragma unroll
        for (int dt = 0; dt < 2; ++dt)
#pragma unroll
            for (int e = 0; e < 16; ++e) O[dt][e] = 0.f;
#pragma nounroll
        for (int ch = 0; ch < 3; ++ch) {
            f32x16 S[3];
#pragma unroll
            for (int c = 0; c < 3; ++c) {
#pragma unroll
                for (int e = 0; e < 16; ++e) S[c][e] = 0.f;
                const unsigned char* kp = Ks + (32 * (qi + 3 * ch + c) + r) * 144 + h * 16;
#pragma unroll
                for (int s = 0; s < 4; ++s) { const bf16x8 kf = *(const bf16x8*)(kp + s * 32); S[c] = __builtin_amdgcn_mfma_f32_32x32x16_bf16(kf, qf[s], S[c], 0, 0, 0); }
            }
            float cmax = -1e30f;
#pragma unroll
            for (int c = 0; c < 3; ++c) {
                const int tp = 3 * ch + c, b3 = (qi + tp) >> 2;
                const bool tv = (b3 == 1) || (b3 == 0 && hasPrev) || (b3 == 2 && hasNext);
#pragma unroll
                for (int e = 0; e < 16; ++e) {
                    const int kk = (e & 3) + 8 * (e >> 2) + 4 * h;
                    bool ok = tv;
                    if (c == 0) ok = ok && (tp != 0 || kk >= r);
                    if (c == 2) ok = ok && (tp != 8 || kk <= r);
                    const float sv = ok ? S[c][e] : -1e30f;
                    S[c][e] = sv; cmax = fmaxf(cmax, sv);
                }
            }
            cmax = fmaxf(cmax, __shfl_xor(cmax, 32));
            const float mnew = fmaxf(mrun, cmax), scl = __expf(mrun - mnew);
            mrun = mnew;
            float psum = 0.f;
#pragma unroll
            for (int c = 0; c < 3; ++c)
#pragma unroll
                for (int e = 0; e < 16; ++e) { const float pv = __expf(S[c][e] - mnew); S[c][e] = pv; psum += pv; }
            psum += __shfl_xor(psum, 32);
            lsum = lsum * scl + psum;
#pragma unroll
            for (int dt = 0; dt < 2; ++dt)
#pragma unroll
                for (int e = 0; e < 16; ++e) O[dt][e] *= scl;
#pragma unroll
            for (int c = 0; c < 3; ++c)
#pragma unroll
                for (int s2 = 0; s2 < 2; ++s2) {
                    u32x4 pp; pp[0] = pk2(S[c][8 * s2 + 0], S[c][8 * s2 + 1]); pp[1] = pk2(S[c][8 * s2 + 2], S[c][8 * s2 + 3]); pp[2] = pk2(S[c][8 * s2 + 4], S[c][8 * s2 + 5]); pp[3] = pk2(S[c][8 * s2 + 6], S[c][8 * s2 + 7]);
                    const bf16x8 pf = __builtin_bit_cast(bf16x8, pp);
#pragma unroll
                    for (int dt = 0; dt < 2; ++dt) {
                        const unsigned char* vp = Vs + (32 * dt + r) * 784 + (32 * (qi + 3 * ch + c) + 16 * s2 + 4 * h) * 2;
                        const u32x2 lo = *(const u32x2*)vp, hi = *(const u32x2*)(vp + 16);
                        u32x4 vv; vv[0] = lo[0]; vv[1] = lo[1]; vv[2] = hi[0]; vv[3] = hi[1];
                        O[dt] = __builtin_amdgcn_mfma_f32_32x32x16_bf16(__builtin_bit_cast(bf16x8, vv), pf, O[dt], 0, 0, 0);
                    }
                }
        }
        const float inv = 1.0f / lsum;
        bf16_t* op = A2 + (size_t)qrow * 1024 + head * 64;
#pragma unroll
        for (int dt = 0; dt < 2; ++dt)
#pragma unroll
            for (int gq = 0; gq < 4; ++gq) {
                u32x2 o; o[0] = pk2(O[dt][4 * gq + 0] * inv, O[dt][4 * gq + 1] * inv); o[1] = pk2(O[dt][4 * gq + 2] * inv, O[dt][4 * gq + 3] * inv);
                *(u32x2*)(op + 32 * dt + 8 * gq + 4 * h) = o;
            }
    }
    __syncthreads();
}

template <int LOGN>
__device__ __forceinline__ void hyena_unit(const Params& p, int l, int hu, unsigned char* smem, bool dry = false) {
    const int zl = launder0(); unsigned char* const wsp = lptr(p.ws);
    const int tid = ltid();
    constexpr int L = 1 << (LOGN - 1), logN = LOGN, N = 2 * L;
    const int bidx = (LOGN == 13 ? 0 : 16) + (hu >> 7), cq = hu & 127;
    const size_t rb = bidx < 16 ? (size_t)bidx * 4096 : 65536 + (size_t)(bidx - 16) * 2048;
    float2* buf = (float2*)smem;
    bf16_t* ZT = (bf16_t*)(wsp + OFF_ZT);
    const float* cw = PIN[16] + (size_t)l * 3 * 1536; const float* cb = PIN[17] + (size_t)l * 1536;
    const int t8 = tid * 8; const bool act = t8 < L;
    float u[2][2][8], x0c[2][2][8];
    if (act) {
#pragma unroll
        for (int pp = 0; pp < 2; ++pp) {
            const int c1 = 4 * cq + 2 * pp;
#pragma unroll
            for (int cc = 0; cc < 2; ++cc) {
                float cv[3][8];
#pragma unroll
                for (int gi = 0; gi < 3; ++gi) {
                    const int col = gi * 512 + c1 + cc;
                    const bf16_t* src = ZT + (size_t)col * MTOT + rb + t8;
                    const u32x4 raw = *(const u32x4*)src;
                    float in[10];
                    in[0] = t8 > 0 ? bf2f(src[-1]) : 0.f;
                    in[9] = (t8 + 8 < L) ? bf2f(src[8]) : 0.f;
#pragma unroll
                    for (int q = 0; q < 4; ++q) { in[1 + 2 * q] = bf_lo(raw[q]); in[2 + 2 * q] = bf_hi(raw[q]); }
                    const float w0 = cw[col], w1 = cw[1536 + col], w2 = cw[3072 + col], bsv = cb[col];
#pragma unroll
                    for (int j = 0; j < 8; ++j) cv[gi][j] = w0 * in[j] + w1 * in[j + 1] + w2 * in[j + 2] + bsv;
                }
#pragma unroll
                for (int j = 0; j < 8; ++j) { u[pp][cc][j] = cv[2][j] * cv[1][j]; x0c[pp][cc][j] = cv[0][j]; }
            }
            float2* bb = buf + pp * FFT_BUF_STRIDE;
#pragma unroll
            for (int j = 0; j < 8; ++j) bb[PIX(t8 + j)] = make_float2(u[pp][0][j], u[pp][1][j]);
        }
    }
    __syncthreads();
    fft_fwd<LOGN, 2, true>(buf, tid);
    {
        const float2* KF = (const float2*)(wsp + OFF_KF);
#pragma unroll
        for (int pp = 0; pp < 2; ++pp) {
            const int c1 = 4 * cq + 2 * pp;
            const float2* K1 = KF + (size_t)l * KF_LAYER + (bidx < 16 ? (size_t)c1 * KS4 : (size_t)512 * KS4 + (size_t)c1 * KS2);
            const float2* K2 = K1 + (bidx < 16 ? KS4 : KS2);
            float2* bb = buf + pp * FFT_BUF_STRIDE;
#pragma unroll
            for (int i = 0; i < 9; ++i) {
                const int k = tid + 512 * i; if (k > L) continue;
                const int pa = (int)(__brev((unsigned)k) >> (32 - logN)), pb = (int)(__brev((unsigned)((N - k) & (N - 1))) >> (32 - logN));
                const float2 a = bb[PIX(pa)], b = bb[PIX(pb)];
                const float u1x = a.x + b.x, u1y = a.y - b.y, u2x = a.y + b.y, u2y = b.x - a.x;
                const float2 k1 = K1[k], k2 = K2[k];
                const float p1x = u1x * k1.x - u1y * k1.y, p1y = u1x * k1.y + u1y * k1.x;
                const float p2x = u2x * k2.x - u2y * k2.y, p2y = u2x * k2.y + u2y * k2.x;
                bb[PIX(pa)] = make_float2(p1x - p2y, p1y + p2x);
                if (pb != pa) bb[PIX(pb)] = make_float2(p1x + p2y, p2x - p1y);
            }
        }
    }
    __syncthreads();
    fft_inv<LOGN, 2, true>(buf, tid);
    if (act) {
#pragma unroll
        for (int pp = 0; pp < 2; ++pp) {
            const int c1 = 4 * cq + 2 * pp;
            const float2* bb = buf + pp * FFT_BUF_STRIDE;
#pragma unroll
            for (int cc = 0; cc < 2; ++cc) {
                const float bias = PIN[27][l * 512 + c1 + cc];
                float o[8];
#pragma unroll
                for (int j = 0; j < 8; ++j) { const float2 y = bb[PIX(t8 + j)]; o[j] = ((cc ? y.y : y.x) + u[pp][cc][j] * bias) * x0c[pp][cc][j]; }
                u32x4 pk; pk[0] = pk2(o[0], o[1]); pk[1] = pk2(o[2], o[3]); pk[2] = pk2(o[4], o[5]); pk[3] = pk2(o[6], o[7]);
                if (!dry) *(u32x4*)(ZT + (size_t)(c1 + cc) * MTOT + rb + t8) = pk;
            }
        }
    }
    __syncthreads();
}

__device__ __forceinline__ void rms_unit(const Params& p, int l, int rc, unsigned char* smem) {
    const int zl = launder0(); unsigned char* const wsp = lptr(p.ws); float* const xp = lptr(p.X); (void)xp;
    const int tid = ltid(), lane = tid & 63, w = tid >> 6;
    const int row0 = rc * 64;
    bf16_t* A2 = (bf16_t*)(wsp + OFF_H);
    const bf16_t* ZT = (const bf16_t*)(wsp + OFF_ZT);
    const float* gn = PIN[15] + (size_t)l * 1024;
    {
        const f32x4 g0 = *(const f32x4*)(gn + lane * 8), g1 = *(const f32x4*)(gn + lane * 8 + 4);
        bf16_t* ap = A2 + (size_t)(row0 + w * 8) * 1024 + lane * 8;
        u32x4 va[8]; float ss[8];
#pragma unroll
        for (int rr = 0; rr < 8; ++rr) va[rr] = *(const u32x4*)(ap + (size_t)rr * 1024);
#pragma unroll
        for (int rr = 0; rr < 8; ++rr) {
            float a = 0.f;
#pragma unroll
            for (int q = 0; q < 4; ++q) { const float lo = bf_lo(va[rr][q]), hi = bf_hi(va[rr][q]); a += lo * lo + hi * hi; }
            ss[rr] = a;
        }
#pragma unroll
        for (int o = 1; o < 64; o <<= 1)
#pragma unroll
            for (int rr = 0; rr < 8; ++rr) ss[rr] += __shfl_xor(ss[rr], o);
#pragma unroll
        for (int rr = 0; rr < 8; ++rr) {
            const float rstd = rsqrtf(ss[rr] * (1.0f / 512.0f) + 1e-6f);
            u32x4 pk;
            pk[0] = pk2(bf_lo(va[rr][0]) * rstd * g0[0], bf_hi(va[rr][0]) * rstd * g0[1]); pk[1] = pk2(bf_lo(va[rr][1]) * rstd * g0[2], bf_hi(va[rr][1]) * rstd * g0[3]);
            pk[2] = pk2(bf_lo(va[rr][2]) * rstd * g1[0], bf_hi(va[rr][2]) * rstd * g1[1]); pk[3] = pk2(bf_lo(va[rr][3]) * rstd * g1[2], bf_hi(va[rr][3]) * rstd * g1[3]);
            *(u32x4*)(ap + (size_t)rr * 1024) = pk;
        }
    }
    bf16_t* T = (bf16_t*)smem;
    {
        const int c = tid;
        u32x4 vv[8];
#pragma unroll
        for (int q = 0; q < 8; ++q) vv[q] = *(const u32x4*)(ZT + (size_t)c * MTOT + row0 + q * 8);
#pragma unroll
        for (int q = 0; q < 8; ++q)
#pragma unroll
            for (int e = 0; e < 4; ++e) { T[(q * 8 + 2 * e) * 520 + c] = (bf16_t)(vv[q][e] & 0xffffu); T[(q * 8 + 2 * e + 1) * 520 + c] = (bf16_t)(vv[q][e] >> 16); }
    }
    __syncthreads();
    {
        const f32x4 g0 = *(const f32x4*)(gn + 512 + lane * 8), g1 = *(const f32x4*)(gn + 512 + lane * 8 + 4);
        u32x4 va[8]; float ss[8];
#pragma unroll
        for (int rr = 0; rr < 8; ++rr) va[rr] = *(const u32x4*)(T + (w * 8 + rr) * 520 + lane * 8);
#pragma unroll
        for (int rr = 0; rr < 8; ++rr) {
            float a = 0.f;
#pragma unroll
            for (int q = 0; q < 4; ++q) { const float lo = bf_lo(va[rr][q]), hi = bf_hi(va[rr][q]); a += lo * lo + hi * hi; }
            ss[rr] = a;
        }
#pragma unroll
        for (int o = 1; o < 64; o <<= 1)
#pragma unroll
            for (int rr = 0; rr < 8; ++rr) ss[rr] += __shfl_xor(ss[rr], o);
#pragma unroll
        for (int rr = 0; rr < 8; ++rr) {
            const float rstd = rsqrtf(ss[rr] * (1.0f / 512.0f) + 1e-6f);
            u32x4 pk;
            pk[0] = pk2(bf_lo(va[rr][0]) * rstd * g0[0], bf_hi(va[rr][0]) * rstd * g0[1]); pk[1] = pk2(bf_lo(va[rr][1]) * rstd * g0[2], bf_hi(va[rr][1]) * rstd * g0[3]);
            pk[2] = pk2(bf_lo(va[rr][2]) * rstd * g1[0], bf_hi(va[rr][2]) * rstd * g1[1]); pk[3] = pk2(bf_lo(va[rr][3]) * rstd * g1[2], bf_hi(va[rr][3]) * rstd * g1[3]);
            *(u32x4*)(A2 + (size_t)(row0 + w * 8 + rr) * 1024 + 512 + lane * 8) = pk;
        }
    }
    __syncthreads();
}

#define LAS __attribute__((address_space(3)))
#define XB_TMO      128
#define XB_XCNT(j)  (256  + 64 * (j))
#define XB_XSUB(j)  (1280 + 64 * (j))
#define XB_XGEN(j)  (2304 + 64 * (j))
#define XB_TOP      3328
#define XB_TOPGEN   3392
#define XCD_BAR_WORDS 3456
#define XB_SPIN_CAP (1u << 18)

__device__ __forceinline__ unsigned xb_ld(unsigned* p)              { return __hip_atomic_load(p, __ATOMIC_RELAXED, __HIP_MEMORY_SCOPE_AGENT); }
__device__ __forceinline__ unsigned xb_add(unsigned* p, unsigned v) { return __hip_atomic_fetch_add(p, v, __ATOMIC_RELAXED, __HIP_MEMORY_SCOPE_AGENT); }
__device__ __forceinline__ unsigned xb_xcc_id() { return (unsigned)__builtin_amdgcn_s_getreg((3 << 11) | 20) & 0xFu; }
#define XB_SPIN(cond, bar) do { unsigned _sp = 0; while (cond) { __builtin_amdgcn_s_sleep(1); \
    if ((++_sp & 255u) == 0u) { if (xb_ld(&(bar)[XB_TMO])) break; if (_sp > XB_SPIN_CAP) { atomicAdd(&(bar)[XB_TMO], 1u); break; } } } } while (0)

struct XcdBarrier {
    unsigned* bar; unsigned x;
    volatile LAS unsigned* st;
};

__device__ __forceinline__ XcdBarrier xcd_barrier_post(unsigned* bar, volatile LAS unsigned* st) {
    XcdBarrier b; b.bar = bar; b.x = xb_xcc_id(); b.st = st;
    if (threadIdx.x == 0) (void)xb_add(&bar[XB_XCNT(b.x)], 1u);
    return b;
}
__device__ __forceinline__ void xcd_barrier_complete(unsigned* bar, unsigned x, unsigned& nloc, unsigned& nx) {
    const unsigned G = gridDim.x * gridDim.y * gridDim.z;
    unsigned sum, cnt, mine, sp = 0u;
    for (;;) {
        sum = 0u; cnt = 0u; mine = 0u;
#pragma unroll
        for (unsigned j = 0; j < 16; ++j) { const unsigned c = xb_ld(&bar[XB_XCNT(j)]); sum += c; cnt += (c > 0u) ? 1u : 0u; mine = (j == x) ? c : mine; }
        if (sum == G) break;
        __builtin_amdgcn_s_sleep(1);
        if ((++sp & 255u) == 0u) { if (xb_ld(&bar[XB_TMO])) break; if (sp > XB_SPIN_CAP) { atomicAdd(&bar[XB_TMO], 1u); break; } }
    }
    nloc = mine > 0u ? mine : 1u; nx = cnt > 0u ? cnt : 1u;
}

__device__ __forceinline__ void xcd_barrier(const XcdBarrier& b) {
    asm volatile("s_waitcnt vmcnt(0)" ::: "memory");
    __syncthreads();
    if (threadIdx.x == 0) {
        unsigned* bar = b.bar;
        __builtin_amdgcn_s_waitcnt(0);
        unsigned nloc = b.st[0], nx = b.st[1];
        if (nloc == 0u) { xcd_barrier_complete(bar, b.x, nloc, nx); b.st[0] = nloc; b.st[1] = nx; }
        const unsigned old = xb_add(&bar[XB_XSUB(b.x)], 1u);
        const unsigned gen = old / nloc;
        if (old + 1u == (gen + 1u) * nloc) {
            __builtin_amdgcn_fence(__ATOMIC_RELEASE, "agent");
            asm volatile("s_waitcnt vmcnt(0)" ::: "memory");
            const unsigned og = xb_add(&bar[XB_TOP], 1u);
            const unsigned tg = og / nx;
            if (og + 1u == (tg + 1u) * nx) xb_add(&bar[XB_TOPGEN], 1u);
            else XB_SPIN(xb_ld(&bar[XB_TOPGEN]) == tg, bar);
            __builtin_amdgcn_fence(__ATOMIC_ACQUIRE, "agent");
            xb_add(&bar[XB_XGEN(b.x)], 1u);
            asm volatile("s_waitcnt vmcnt(0)" ::: "memory");
        } else {
            XB_SPIN(xb_ld(&bar[XB_XGEN(b.x)]) == gen, bar);
            __builtin_amdgcn_fence(__ATOMIC_ACQUIRE, "agent");
            asm volatile("s_waitcnt vmcnt(0)" ::: "memory");
        }
    }
    __syncthreads();
}

__global__ void __launch_bounds__(512) hymba_fwd(Params p) {
    extern __shared__ __attribute__((aligned(16))) unsigned char smem[];
    cg::grid_group grid = cg::this_grid();
    volatile LAS unsigned* bst = (volatile LAS unsigned*)(smem + 135168 + 512);
    if (threadIdx.x < 2) bst[threadIdx.x] = 0u;
    __syncthreads();
    XcdBarrier xbar = xcd_barrier_post((unsigned*)(p.ws + OFF_BAR), bst);
    PG8_LAS unsigned char* lds = (PG8_LAS unsigned char*)smem;
    const int G = gridDim.x, wg = blockIdx.x;
    for (int ph = p.ph_lo; ph < p.ph_hi; ++ph) {
        const int zl = launder0(); unsigned char* const wsp = lptr(p.ws); float* const xp = lptr(p.X);
        bf16_t* Hb = (bf16_t*)(wsp + OFF_H); bf16_t* ACT = (bf16_t*)(wsp + OFF_ACT); float* MOD = (float*)(wsp + OFF_MOD);
#ifdef PROBE_P0
        if (ph == 0) { phase0a(p, smem); __syncthreads(); }
        if (ph == 1) { phase0b(p, smem); __syncthreads(); }
#endif
        if (EN_P0 && ph == 0) phase0a(p, smem);
        else if (EN_P1 && ph == 1) phase0b(p, smem);
        else {
            const int l = (ph - 2) / 11, s = (ph - 2) % 11;
            const bf16_t* wl = (const bf16_t*)(wsp + OFF_W) + (size_t)l * WL_ELEMS;
            if (EN_GEMM && (s == 0 || s == 8 || s == 1 || s == 9 || s == 3 || s == 6)) {
                const int nsub = (s == 3) ? 2 : 1;
                for (int sub = 0; sub < nsub; ++sub) {
                    pg8::Gemm g; pg8::EpiAny E;
                    E.O = ACT; E.ldc = 2816; E.X = xp; E.gate = MOD; E.coef = 0.5f; E.mode = 0; E.perm = true;
                    E.stats = (const float2*)(wsp + OFF_STATS); E.lng = nullptr; E.lnb = nullptr;
                    if (s == 0 || s == 8) { g.A = Hb; g.Bt = wl + (s ? WO_WI2 : WO_WI1); g.M = MTOT; g.N = 5632; g.K = 1024; }
                    else if (s == 1 || s == 9) { g.A = ACT; g.Bt = wl + (s == 9 ? WO_WO2 : WO_WO1); g.M = MTOT; g.N = 1024; g.K = 2816;
                        E.mode = 1; E.perm = false; E.gate = MOD + (size_t)l * 32 * 9216 + (s == 9 ? 8 : 2) * 1024;
                        const int lnrow = (s == 9) ? l * 3 + 1 : l * 3 - 1;
                        if (lnrow >= 0) { E.lng = PIN[10] + (size_t)lnrow * 1024; E.lnb = PIN[11] + (size_t)lnrow * 1024; } }
                    else if (s == 6) { g.A = Hb; g.Bt = wl + WO_WOUT; g.M = MTOT; g.N = 1024; g.K = 1024;
                        E.mode = 1; E.perm = false; E.gate = MOD + (size_t)l * 32 * 9216 + 5 * 1024; E.coef = 1.0f;
                        E.lng = PIN[10] + (size_t)(l * 3) * 1024; E.lnb = PIN[11] + (size_t)(l * 3) * 1024; }
                    else if (sub == 0) { g.A = Hb; g.Bt = wl + WO_WINA; g.M = MTOT; g.N = 768; g.K = 1024; E.mode = 2; E.O = (bf16_t*)(wsp + OFF_ZA); E.ldc = 768; }
                    else { g.A = wl + WO_WINB; g.Bt = Hb; g.M = 1792; g.N = MTOT; g.K = 1024; E.mode = 2; E.O = (bf16_t*)(wsp + OFF_ZT); E.ldc = (size_t)MTOT; }
                    pg8::StaticOrder S; S.init(g.M, g.N, G, (s == 3 && sub == 1) ? G - 1 - wg : wg);
                    pg8::gemm_phase<pg8::EpiAny, pg8::StaticOrder>(lds, g, S, E, nullptr);
                }
            } else if (EN_LN && (s == 2 || s == 7 || s == 10)) {
                const int li = s == 2 ? 0 : (s == 7 ? 1 : 2);
                const float* md = nullptr;
                if (s == 2) md = MOD + (size_t)l * 32 * 9216 + 3 * 1024;
                else if (s == 7) md = MOD + (size_t)l * 32 * 9216 + 6 * 1024;
                else if (l + 1 < NLAYER) md = MOD + (size_t)(l + 1) * 32 * 9216;
#ifdef PROBE_LN
                if (md) lnmod_phase(wsp, xp, PIN[10] + (size_t)(l * 3 + li) * 1024, PIN[11] + (size_t)(l * 3 + li) * 1024, md, md == nullptr);
#endif
                lnmod_phase(wsp, xp, PIN[10] + (size_t)(l * 3 + li) * 1024, PIN[11] + (size_t)(l * 3 + li) * 1024, md, md == nullptr);
            } else if (s == 4) {
#ifdef PROBE_ATT
                for (int ua = wg; ua < 1536; ua += G) attn_unit(p, l, ua, smem);
#endif
#ifdef PROBE_HY
                { for (int hu = wg; hu < 2048; hu += G) hyena_unit<13>(p, l, hu, smem, launder0() == 0); for (int hu = wg; hu < 2048; hu += G) hyena_unit<12>(p, l, hu, smem, launder0() == 0); }
#endif
                if (EN_ATT) for (int ua = wg; ua < 1536; ua += G) attn_unit(p, l, ua, smem);
                if (EN_HY) { for (int hu = wg; hu < 2048; hu += G) hyena_unit<13>(p, l, hu, smem); for (int hu = wg; hu < 2048; hu += G) hyena_unit<12>(p, l, hu, smem); }
            } else if (EN_RMS && s == 5) {
                for (int rc = wg; rc < 1536; rc += G) rms_unit(p, l, rc, smem);
            }
        }
#ifdef PROBE_SYNC
        if (ph + 1 < p.ph_hi) { grid.sync(); grid.sync(); grid.sync(); }
#endif
        if (ph + 1 < p.ph_hi) { if (ph == 0) grid.sync(); else xcd_barrier(xbar); }
    }
}

extern "C" void kernel_launch(void* const* d_in, const int* in_sizes, int n_in, void* d_out, int out_size, void* d_ws, size_t ws_size, hipStream_t stream) {
    static int grid = 0;
    if (grid == 0) {
        if (n_in != 28 || ws_size < WS_NEED) { fprintf(stderr, "kernel_launch: unexpected n_in %d or ws_size %zu (need %zu)\n", n_in, ws_size, (size_t)WS_NEED); grid = -1; return; }
        int dev = 0, cus = 0, per_cu = 0;
        (void)hipGetDevice(&dev);
        (void)hipDeviceGetAttribute(&cus, hipDeviceAttributeMultiprocessorCount, dev);
        if (hipFuncSetAttribute((const void*)hymba_fwd, hipFuncAttributeMaxDynamicSharedMemorySize, LDS_BYTES) != hipSuccess) { fprintf(stderr, "kernel_launch: hipFuncSetAttribute failed\n"); grid = -1; return; }
        if (hipOccupancyMaxActiveBlocksPerMultiprocessor(&per_cu, (const void*)hymba_fwd, 512, LDS_BYTES) != hipSuccess || per_cu < 1) { fprintf(stderr, "kernel_launch: occupancy query gave %d\n", per_cu); per_cu = 1; }
        (void)hipGetLastError();
        grid = cus * 1;
        if (grid <= 0) grid = 256;
    }
    if (grid < 0) return;
    Params p{};
    for (int i = 0; i < 28; ++i) p.in[i] = (const float*)d_in[i];
    p.X = (float*)d_out; p.ws = (unsigned char*)d_ws; p.ph_lo = 0; p.ph_hi = NPHASE;
    if (hipMemsetAsync((unsigned char*)d_ws + OFF_BAR, 0, BAR_BYTES, stream) != hipSuccess) { fprintf(stderr, "kernel_launch: memset of the barrier words failed\n"); return; }
    void* args[] = {&p};
    hipError_t e = hipLaunchCooperativeKernel((const void*)hymba_fwd, dim3(grid), dim3(512), args, LDS_BYTES, stream);
    if (e != hipSuccess) fprintf(stderr, "kernel_launch: cooperative launch failed: %s (grid %d)\n", hipGetErrorString(e), grid);
}
```

```cpp
#include <hip/hip_runtime.h>
#include <hip/hip_cooperative_groups.h>
#include <cstdio>
#include <cstdint>
namespace cg = cooperative_groups;
__device__ __forceinline__ int ltid() { int t = threadIdx.x; asm volatile("" : "+v"(t)); return t; }
template <class T> __device__ __forceinline__ T* lptr(T* q) { int z = 0; asm volatile("" : "+s"(z)); return q + z; }
namespace pg8 {
#define PG8_LAS __attribute__((address_space(3)))
typedef unsigned short bf16_t;
typedef short bf16x8 __attribute__((ext_vector_type(8)));
typedef float f32x4 __attribute__((ext_vector_type(4)));
typedef unsigned u32x4 __attribute__((ext_vector_type(4)));
constexpr int BM = 256, BK = 64, HALF = 128, HTB = HALF * BK * 2  , STAGE_BYTES = 8 * HTB, NXCD = 8, WGM = 8;

__host__ __device__ __forceinline__ int lds_byte(int r, int c) { const int st = (r >> 4) * 2 + (c >> 5), rr = r & 15, cc = c & 31, ob = rr * 64 + cc * 2; return st * 1024 + (ob ^ (((ob >> 9) & 1) << 5)); }
__host__ __device__ __forceinline__ void stage_rc(int b, int& R, int& C) { const int st = b / 1024, sb = b % 1024, swz = sb ^ (((sb >> 9) & 1) << 5); R = (st >> 1) * 16 + swz / 64; C = (st & 1) * 32 + (swz % 64) / 2; }
__host__ __device__ __forceinline__ int perm32(int rho) { const int n = rho >> 4, i = rho & 15; return 8 * (i >> 2) + 4 * n + (i & 3); }

struct Unit { int pm, pn; };
struct Gemm { const bf16_t* A; const bf16_t* Bt; int M, N, K; };
struct StaticOrder {
    int nM, nN, nwg, G, c;
    __host__ __device__ void init(int M, int N, int G_, int c_) { nM = M / BM; nN = N / BM; nwg = nM * nN; G = G_; c = c_; }
    __host__ __device__ bool next(int i, Unit& u) const {
        const long L = (long)i * G + c; if (L >= nwg) return false;
        int wgid = (int)L; { const int q = nwg / NXCD, r = nwg % NXCD, xcd = wgid % NXCD, off = wgid / NXCD; wgid = (xcd < r ? xcd * (q + 1) : r * (q + 1) + (xcd - r) * q) + off; }
        const int nig = WGM * nN, gid = wgid / nig, fm = gid * WGM, gsz = (nM - fm) < WGM ? (nM - fm) : WGM;
        u.pm = fm + ((wgid % nig) % gsz); u.pn = (wgid % nig) / gsz; return true;
    }
    __device__ __forceinline__ void a_ready(const Unit&) const {}
    __device__ __forceinline__ void done(const Unit&) const {}
};
__device__ __forceinline__ unsigned cvt_pk_bf16(float lo, float hi) { unsigned r; asm volatile("v_cvt_pk_bf16_f32 %0, %1, %2" : "=v"(r) : "v"(lo), "v"(hi)); return r; }
struct EpiSwiGLU {
    static constexpr bool PERM = true, AFTER_DRAIN = false;
    bf16_t* O;
    __device__ __forceinline__ void operator()(const f32x4 (&acc)[2][2][4][2], const Unit& u, int wr, int wc, int fr, int fq) const {
        const int row0 = u.pm * BM + wr * 64 + fr, col0 = u.pn * 128 + wc * 32 + 8 * fq;
#pragma unroll
        for (int ai = 0; ai < 2; ++ai)
#pragma unroll
            for (int m = 0; m < 4; ++m) {
                bf16_t* p = O + (size_t)(row0 + ai * HALF + m * 16) * 2816 + col0;
                float v[8];
#pragma unroll
                for (int n = 0; n < 2; ++n)
#pragma unroll
                    for (int j = 0; j < 4; ++j) { const float g = acc[ai][0][m][n][j], uu = acc[ai][1][m][n][j]; v[n * 4 + j] = g * uu * __builtin_amdgcn_rcpf(1.0f + __expf(-g)); }
                u32x4 pk; pk[0] = cvt_pk_bf16(v[0], v[1]); pk[1] = cvt_pk_bf16(v[2], v[3]); pk[2] = cvt_pk_bf16(v[4], v[5]); pk[3] = cvt_pk_bf16(v[6], v[7]);
                *(u32x4*)p = pk;
            }
    }
};
struct EpiResid {
    static constexpr bool PERM = false, AFTER_DRAIN = false;
    float* X; const float* gate; float coef; const float2* stats; const float* lng; const float* lnb;
    __device__ __forceinline__ void operator()(const f32x4 (&acc)[2][2][4][2], const Unit& u, int wr, int wc, int fr, int fq) const {
        const int bidx = u.pm < 256 ? (u.pm >> 4) : 16 + ((u.pm - 256) >> 3);
        const int row0 = u.pm * BM + wr * 64 + fr, col0 = u.pn * BM + wc * 32 + 4 * fq;
        const float* gp = gate + (size_t)bidx * 9216 + col0;
        float mu[2][4], rs[2][4];
#pragma unroll
        for (int ai = 0; ai < 2; ++ai)
#pragma unroll
            for (int m = 0; m < 4; ++m) {
                mu[ai][m] = 0.f; rs[ai][m] = 1.f;
                if (lng) { const float2 st = stats[row0 + ai * HALF + m * 16]; mu[ai][m] = st.x; rs[ai][m] = st.y; }
            }
#pragma unroll
        for (int bj = 0; bj < 2; ++bj)
#pragma unroll
            for (int n = 0; n < 2; ++n) {
                const int co = bj * HALF + n * 16;
                const f32x4 gt = (*(const f32x4*)(gp + co) + 1.0f) * coef;
                f32x4 gg = {1.f, 1.f, 1.f, 1.f}, be = {0.f, 0.f, 0.f, 0.f};
                if (lng) { gg = *(const f32x4*)(lng + col0 + co); be = *(const f32x4*)(lnb + col0 + co); }
#pragma unroll
                for (int ai = 0; ai < 2; ++ai)
#pragma unroll
                    for (int m = 0; m < 4; ++m) {
                        float* ptr = X + (size_t)(row0 + ai * HALF + m * 16) * 1024 + col0 + co;
                        const f32x4 xv = *(const f32x4*)ptr;
                        const f32x4 xl = (xv - mu[ai][m]) * rs[ai][m] * gg + be;
                        *(f32x4*)ptr = xl * 1.681792830507429f + gt * acc[ai][bj][m][n];
                    }
            }
    }
};
struct EpiStore {
    static constexpr bool PERM = true, AFTER_DRAIN = false;
    bf16_t* O; size_t ldc;
    __device__ __forceinline__ void operator()(const f32x4 (&acc)[2][2][4][2], const Unit& u, int wr, int wc, int fr, int fq) const {
        const int row0 = u.pm * BM + wr * 64 + fr, col0 = u.pn * BM + wc * 32 + 8 * fq;
#pragma unroll
        for (int ai = 0; ai < 2; ++ai)
#pragma unroll
            for (int m = 0; m < 4; ++m) { bf16_t* p = O + (size_t)(row0 + ai * HALF + m * 16) * ldc + col0;
#pragma unroll
                for (int bj = 0; bj < 2; ++bj) { const f32x4 v0 = acc[ai][bj][m][0], v1 = acc[ai][bj][m][1];
                    u32x4 pk; pk[0] = cvt_pk_bf16(v0[0], v0[1]); pk[1] = cvt_pk_bf16(v0[2], v0[3]); pk[2] = cvt_pk_bf16(v1[0], v1[1]); pk[3] = cvt_pk_bf16(v1[2], v1[3]);
                    *(u32x4*)(p + bj * HALF) = pk; } }
    }
};

struct EpiAny {
    static constexpr bool AFTER_DRAIN = false;
    int mode; bool perm; bf16_t* O; size_t ldc; float* X; const float* gate; float coef; const float2* stats; const float* lng; const float* lnb;
    __device__ __forceinline__ void operator()(const f32x4 (&acc)[2][2][4][2], const Unit& u, int wr, int wc, int fr, int fq) const {
        if (mode == 0) { EpiSwiGLU e{O}; e(acc, u, wr, wc, fr, fq); }
        else if (mode == 1) { EpiResid e{X, gate, coef, stats, lng, lnb}; e(acc, u, wr, wc, fr, fq); }
        else { EpiStore e{O, ldc}; e(acc, u, wr, wc, fr, fq); }
    }
};
template <class Epi, class Sched, bool ALIGN_EPI = false, bool SP2 = false>
__device__ __forceinline__ void gemm_phase(PG8_LAS unsigned char* lds, const Gemm g, const Sched& S, const Epi& E) {
    const int tid = ltid(), wid = __builtin_amdgcn_readfirstlane(tid >> 6), lane = tid & 63, wr = wid >> 2, wc = wid & 3, fr = lane & 15, fq = lane >> 4;
    const int K = g.K, nt = K / BK;
    unsigned voffA[2], voffB[2];
#pragma unroll
    for (int i = 0; i < 2; ++i) { int R, C; stage_rc(tid * 16 + i * 8192, R, C); const int Rb = E.perm ? ((R & ~31) + perm32(R & 31)) : R;
        voffA[i] = (unsigned)(R * K + C) * 2u; voffB[i] = (unsigned)(Rb * K + C) * 2u; }
    const size_t kstep = (size_t)(BK * 2);
    const size_t hstep = (size_t)HALF * K * 2;
    const size_t tstep = 2 * hstep;
    const unsigned ldsw = (unsigned)wid * 1024u;
    const int aoff = lds_byte(wr * 64 + fr, fq * 8), boff = lds_byte(wc * 32 + fr, fq * 8);
#define PG8_SA(b, h) (((b) * 2 + (h)) * HTB)
#define PG8_SB(b, h) ((4 + (b) * 2 + (h)) * HTB)
#define PG8_STAGE(bufoff, gbase, voff) do { _Pragma("unroll") for (int _i = 0; _i < 2; ++_i) \
        __builtin_amdgcn_global_load_lds((const unsigned*)((const char*)(gbase) + (voff)[_i]), (PG8_LAS unsigned*)(lds + (bufoff) + ldsw + _i * 8192), 16, 0, 0); } while (0)
#define PG8_LDA(dst, b, h) do { _Pragma("unroll") for (int m = 0; m < 4; ++m) _Pragma("unroll") for (int k = 0; k < 2; ++k) dst[m][k] = *(const PG8_LAS bf16x8*)(lds + PG8_SA(b, h) + aoff + m * 2048 + k * 1024); } while (0)
#define PG8_LDB(dst, b, h) do { _Pragma("unroll") for (int n = 0; n < 2; ++n) _Pragma("unroll") for (int k = 0; k < 2; ++k) dst[n][k] = *(const PG8_LAS bf16x8*)(lds + PG8_SB(b, h) + boff + n * 2048 + k * 1024); } while (0)
#define PG8_MMA(ai, bj, At, Bt) do { __builtin_amdgcn_s_setprio(1); _Pragma("unroll") for (int m = 0; m < 4; ++m) _Pragma("unroll") for (int n = 0; n < 2; ++n) _Pragma("unroll") for (int k = 0; k < 2; ++k) \
        acc[ai][bj][m][n] = __builtin_amdgcn_mfma_f32_16x16x32_bf16(Bt[n][k], At[m][k], acc[ai][bj][m][n], 0, 0, 0); __builtin_amdgcn_s_setprio(0); } while (0)
#define PG8_WAIT_V(n) asm volatile("s_waitcnt vmcnt(" #n ")" ::: "memory")
#define PG8_WAIT_L(n) asm volatile("s_waitcnt lgkmcnt(" #n ")" ::: "memory")
#define PG8_BAR __builtin_amdgcn_s_barrier()
#define PG8_SCHED __builtin_amdgcn_sched_barrier(0)
    Unit cur, nxt; int ui = 0;
    if (!S.next(0, cur)) return;
    f32x4 acc[2][2][4][2];
#pragma unroll
    for (int a = 0; a < 2; ++a)
#pragma unroll
        for (int b = 0; b < 2; ++b)
#pragma unroll
            for (int m = 0; m < 4; ++m)
#pragma unroll
                for (int n = 0; n < 2; ++n) acc[a][b][m][n] = (f32x4){0.f, 0.f, 0.f, 0.f};
    bf16x8 At[4][2], B0[2][2], B1[2][2];
    const char* cA = (const char*)g.A + (size_t)cur.pm * tstep; const char* cB = (const char*)g.Bt + (size_t)cur.pn * tstep;
    S.a_ready(cur);
    if constexpr (SP2) {
        PG8_STAGE(PG8_SB(0, 0), cB, voffB); PG8_STAGE(PG8_SB(0, 1), cB + hstep, voffB); PG8_STAGE(PG8_SA(0, 0), cA, voffA); PG8_STAGE(PG8_SA(0, 1), cA + hstep, voffA);
        if (wr == 1) PG8_BAR;
        PG8_WAIT_V(2); PG8_BAR;
        PG8_STAGE(PG8_SB(1, 0), cB + kstep, voffB); PG8_STAGE(PG8_SA(1, 0), cA + kstep, voffA); PG8_STAGE(PG8_SB(1, 1), cB + hstep + kstep, voffB);
        PG8_WAIT_V(6); PG8_BAR;
    } else {
        PG8_STAGE(PG8_SB(0, 0), cB, voffB); PG8_STAGE(PG8_SA(0, 0), cA, voffA); PG8_STAGE(PG8_SB(0, 1), cB + hstep, voffB); PG8_STAGE(PG8_SA(0, 1), cA + hstep, voffA);
        if (wr == 1) PG8_BAR;
        PG8_WAIT_V(4); PG8_BAR;
        PG8_STAGE(PG8_SB(1, 0), cB + kstep, voffB); PG8_STAGE(PG8_SA(1, 0), cA + kstep, voffA); PG8_STAGE(PG8_SB(1, 1), cB + hstep + kstep, voffB);
        PG8_WAIT_V(6); PG8_BAR;
    }
    for (;;) {
        const bool has_next = S.next(ui + 1, nxt);
        const char* nA = has_next ? (const char*)g.A + (size_t)nxt.pm * tstep : cA; const char* nB = has_next ? (const char*)g.Bt + (size_t)nxt.pn * tstep : cB;
        for (int t = 0; t < nt; t += 2) {
            const bool last = (t == nt - 2);
            const char* a1 = cA + (size_t)(t + 1) * kstep;
            const char* a2 = last ? nA : cA + (size_t)(t + 2) * kstep; const char* b2 = last ? nB : cB + (size_t)(t + 2) * kstep;
            const char* a3 = a2 + kstep; const char* b3 = b2 + kstep;
            if (last && has_next) S.a_ready(nxt);
            if constexpr (SP2) {
            PG8_LDB(B0, 0, 0); PG8_LDB(B1, 0, 1); PG8_SCHED; PG8_LDA(At, 0, 0); PG8_STAGE(PG8_SA(1, 1), a1 + hstep, voffA);
            PG8_WAIT_V(8); PG8_WAIT_L(0); PG8_BAR; PG8_MMA(0, 0, At, B0); PG8_MMA(0, 1, At, B1); PG8_BAR; PG8_SCHED;
            PG8_LDA(At, 0, 1); PG8_STAGE(PG8_SB(0, 0), b2, voffB); PG8_STAGE(PG8_SB(0, 1), b2 + hstep, voffB); PG8_STAGE(PG8_SA(0, 0), a2, voffA);
            PG8_WAIT_V(8); PG8_WAIT_L(0); PG8_BAR; PG8_MMA(1, 0, At, B0); PG8_MMA(1, 1, At, B1); PG8_BAR; PG8_SCHED;
            PG8_LDB(B0, 1, 0); PG8_LDB(B1, 1, 1); PG8_SCHED; PG8_LDA(At, 1, 0); PG8_STAGE(PG8_SA(0, 1), a2 + hstep, voffA);
            PG8_WAIT_V(8); PG8_WAIT_L(0); PG8_BAR; PG8_MMA(0, 0, At, B0); PG8_MMA(0, 1, At, B1); PG8_BAR; PG8_SCHED;
            PG8_LDA(At, 1, 1); PG8_STAGE(PG8_SB(1, 0), b3, voffB); PG8_STAGE(PG8_SB(1, 1), b3 + hstep, voffB); PG8_STAGE(PG8_SA(1, 0), a3, voffA);
            PG8_WAIT_V(8); PG8_WAIT_L(0); PG8_BAR; PG8_MMA(1, 0, At, B0); PG8_MMA(1, 1, At, B1); PG8_BAR; PG8_SCHED;
            } else {
            PG8_LDB(B0, 0, 0); PG8_SCHED; PG8_LDA(At, 0, 0); PG8_STAGE(PG8_SA(1, 1), a1 + hstep, voffA);
            PG8_WAIT_L(8); PG8_BAR; PG8_WAIT_L(0); PG8_MMA(0, 0, At, B0); PG8_BAR; PG8_SCHED;
            PG8_LDB(B1, 0, 1); PG8_STAGE(PG8_SB(0, 0), b2, voffB);
            PG8_BAR; PG8_WAIT_L(0); PG8_MMA(0, 1, At, B1); PG8_BAR;
            PG8_LDA(At, 0, 1); PG8_STAGE(PG8_SA(0, 0), a2, voffA);
            PG8_BAR; PG8_WAIT_L(0); PG8_MMA(1, 0, At, B0); PG8_BAR; PG8_SCHED;
            PG8_STAGE(PG8_SB(0, 1), b2 + hstep, voffB);
            PG8_WAIT_V(6); PG8_BAR; PG8_MMA(1, 1, At, B1); PG8_BAR;
            PG8_LDB(B0, 1, 0); PG8_SCHED; PG8_LDA(At, 1, 0); PG8_STAGE(PG8_SA(0, 1), a2 + hstep, voffA);
            PG8_WAIT_L(8); PG8_BAR; PG8_WAIT_L(0); PG8_MMA(0, 0, At, B0); PG8_BAR; PG8_SCHED;
            PG8_LDB(B1, 1, 1); PG8_STAGE(PG8_SB(1, 0), b3, voffB);
            PG8_BAR; PG8_WAIT_L(0); PG8_MMA(0, 1, At, B1); PG8_BAR;
            PG8_LDA(At, 1, 1); PG8_STAGE(PG8_SA(1, 0), a3, voffA);
            PG8_BAR; PG8_WAIT_L(0); PG8_MMA(1, 0, At, B0); PG8_BAR; PG8_SCHED;
            PG8_STAGE(PG8_SB(1, 1), b3 + hstep, voffB);
            PG8_WAIT_V(6); PG8_BAR; PG8_MMA(1, 1, At, B1); PG8_BAR;
            }
        }
        if constexpr (ALIGN_EPI) { if (wr == 0) PG8_BAR; }
        if constexpr (!Epi::AFTER_DRAIN) { E(acc, cur, wr, wc, fr, fq); S.done(cur); }
        if (!has_next) break;
#pragma unroll
        for (int a = 0; a < 2; ++a)
#pragma unroll
            for (int b = 0; b < 2; ++b)
#pragma unroll
                for (int m = 0; m < 4; ++m)
#pragma unroll
                    for (int n = 0; n < 2; ++n) acc[a][b][m][n] = (f32x4){0.f, 0.f, 0.f, 0.f};
        cur = nxt; cA = nA; cB = nB; ++ui;
        if constexpr (ALIGN_EPI) { if (wr == 1) PG8_BAR; }
    }
    PG8_WAIT_V(0);
    if constexpr (!ALIGN_EPI) { if (wr == 0) PG8_BAR; }
    PG8_BAR;
    if constexpr (Epi::AFTER_DRAIN) { E.fused(acc, cur, wr, wc, fr, fq, lds, wid, lane); S.done(cur); }
#undef PG8_SA
#undef PG8_SB
#undef PG8_STAGE
#undef PG8_LDA
#undef PG8_LDB
#undef PG8_MMA
#undef PG8_WAIT_V
#undef PG8_WAIT_L
#undef PG8_BAR
#undef PG8_SCHED
}
}

typedef unsigned short bf16_t;
typedef short bf16x8 __attribute__((ext_vector_type(8)));
typedef float f32x4 __attribute__((ext_vector_type(4)));
typedef float f32x16 __attribute__((ext_vector_type(16)));
typedef unsigned u32x4 __attribute__((ext_vector_type(4)));
typedef unsigned u32x2 __attribute__((ext_vector_type(2)));

constexpr int MTOT = 98304, NLAYER = 4;
constexpr size_t WL_ELEMS = 20971520;
constexpr size_t WO_WI1 = 0, WO_WO1 = 5767168, WO_WI2 = 8650752, WO_WO2 = 14417920, WO_WINA = 17301504, WO_WINB = 18087936, WO_WOUT = 19922944;
constexpr size_t OFF_W = 0;
constexpr size_t OFF_MOD = 167772160;
constexpr size_t OFF_ROPE = OFF_MOD + 4718592;
constexpr size_t OFF_H3 = OFF_ROPE + 262144;
constexpr size_t OFF_KF = OFF_H3 + 6291456;
constexpr int KS4 = 4104, KS2 = 2056;
constexpr size_t KF_LAYER = (size_t)512 * (KS4 + KS2);
constexpr size_t OFF_H = OFF_KF + 4 * KF_LAYER * 8;
constexpr size_t OFF_ACT = OFF_H + (size_t)MTOT * 1024 * 2;
constexpr size_t OFF_ZA = OFF_ACT;
constexpr size_t OFF_ZT = OFF_ACT + (size_t)MTOT * 768 * 2;
constexpr size_t OFF_STATS = OFF_ACT + (size_t)MTOT * 2816 * 2;
constexpr size_t OFF_BAR = OFF_STATS + (size_t)MTOT * 8;
constexpr size_t BAR_BYTES = 16384;
constexpr size_t WS_NEED = OFF_BAR + BAR_BYTES;
static_assert(OFF_ZT + (size_t)1792 * MTOT * 2 <= OFF_STATS, "mixer overlay fits");
constexpr int LDS_BYTES = 137216;
constexpr int NPHASE = 2 + 11 * NLAYER;
#ifndef GEMM_ALIGN
#define GEMM_ALIGN true
#endif
#ifndef GEMM_SP2
#define GEMM_SP2 true
#endif
#ifndef EN_GEMM
#define EN_GEMM 1
#endif
#ifndef EN_LN
#define EN_LN 1
#endif
#ifndef EN_ATT
#define EN_ATT 1
#endif
#ifndef EN_HY
#define EN_HY 1
#endif
#ifndef EN_RMS
#define EN_RMS 1
#endif
#ifndef EN_P0
#define EN_P0 1
#endif
#ifndef EN_P1
#define EN_P1 1
#endif

struct Params { const float* in[28]; float* X; unsigned char* ws; int ph_lo, ph_hi; };
#define PIN (p.in + zl)
__device__ __forceinline__ int launder0() { int z = 0; asm volatile("" : "+s"(z)); return z; }

__device__ __forceinline__ float bf_lo(unsigned u) { return __uint_as_float(u << 16); }
__device__ __forceinline__ float bf_hi(unsigned u) { return __uint_as_float(u & 0xffff0000u); }
__device__ __forceinline__ float bf2f(bf16_t b) { return __uint_as_float(((unsigned)b) << 16); }
__device__ __forceinline__ unsigned pk2(float lo, float hi) { return pg8::cvt_pk_bf16(lo, hi); }
__device__ __forceinline__ float sin_rev(float r) { return __builtin_amdgcn_sinf(r); }
__device__ __forceinline__ float cos_rev(float r) { return __builtin_amdgcn_cosf(r); }
__device__ __forceinline__ float sin_rad(float x) { float r = x * 0.15915494309189535f; r -= rintf(r); return __builtin_amdgcn_sinf(r); }
__device__ __forceinline__ float cos_rad(float x) { float r = x * 0.15915494309189535f; r -= rintf(r); return __builtin_amdgcn_cosf(r); }
__device__ __forceinline__ float wave_sum(float v) {
#pragma unroll
    for (int o = 1; o < 64; o <<= 1) v += __shfl_xor(v, o);
    return v;
}
__device__ __forceinline__ int row_bidx(int row) { return row < 65536 ? (row >> 12) : 16 + ((row - 65536) >> 11); }

__device__ __forceinline__ void cvt_tile(const float* __restrict__ src, int ldN, int k0, int c0, bf16_t* __restrict__ dst, int ldK, int n0, bool zero, float* tile) {
    const int tid = ltid();
    {
        const int r = tid >> 4, c4 = (tid & 15) * 4;
#pragma unroll
        for (int ps = 0; ps < 2; ++ps) {
            const int k = r + 32 * ps;
            f32x4 v = {0.f, 0.f, 0.f, 0.f};
            if (!zero) v = *(const f32x4*)(src + (size_t)(k0 + k) * ldN + c0 + c4);
            tile[k * 65 + c4 + 0] = v[0]; tile[k * 65 + c4 + 1] = v[1]; tile[k * 65 + c4 + 2] = v[2]; tile[k * 65 + c4 + 3] = v[3];
        }
    }
    __syncthreads();
    {
        const int n = tid >> 3, kq = tid & 7;
        float f[8];
#pragma unroll
        for (int j = 0; j < 8; ++j) f[j] = tile[(kq * 8 + j) * 65 + n];
        u32x4 pk; pk[0] = pk2(f[0], f[1]); pk[1] = pk2(f[2], f[3]); pk[2] = pk2(f[4], f[5]); pk[3] = pk2(f[6], f[7]);
        *(u32x4*)(dst + (size_t)(n0 + n) * ldK + k0 + kq * 8) = pk;
    }
    __syncthreads();
}

__device__ __forceinline__ void phase0a(const Params& p, unsigned char* smem) {
    const int zl = launder0(); unsigned char* const wsp = lptr(p.ws); float* const xp = lptr(p.X); (void)xp;
    const int tid = ltid();
    float* tile = (float*)smem;
    for (int t = blockIdx.x; t < 20480; t += gridDim.x) {
        const int l = t / 5120, r = t % 5120;
        bf16_t* wl = (bf16_t*)(wsp + OFF_W) + (size_t)l * WL_ELEMS;
        const float* src; int ldN, k0, c0, ldK, n0; bf16_t* dst; bool zero = false;
        if (r < 2816) {
            const int which = r / 1408, rr = r % 1408, nt = rr / 16, kt = rr % 16;
            src = PIN[which ? 8 : 6] + (size_t)l * 1024 * 5632; ldN = 5632; k0 = kt * 64; n0 = nt * 64;
            const int tt = n0 >> 8, within = n0 & 255;
            c0 = within < 128 ? 128 * tt + within : 2816 + 128 * tt + (within - 128);
            dst = wl + (which ? WO_WI2 : WO_WI1); ldK = 1024;
        } else if (r < 4224) {
            const int q = r - 2816, which = q / 704, rr = q % 704, nt = rr / 44, kt = rr % 44;
            src = PIN[which ? 9 : 7] + (size_t)l * 2816 * 1024; ldN = 1024; k0 = kt * 64; n0 = nt * 64; c0 = n0;
            dst = wl + (which ? WO_WO2 : WO_WO1); ldK = 2816;
        } else if (r < 4416) {
            const int q = r - 4224, nt = q / 16, kt = q % 16;
            src = PIN[12] + (size_t)l * 1024 * 2304; ldN = 2304; k0 = kt * 64; n0 = nt * 64; c0 = n0;
            dst = wl + WO_WINA; ldK = 1024;
        } else if (r < 4864) {
            const int q = r - 4416, nt = q / 16, kt = q % 16;
            src = PIN[12] + (size_t)l * 1024 * 2304; ldN = 2304; k0 = kt * 64; n0 = nt * 64;
            if (n0 < 1536) c0 = 768 + n0; else if (n0 < 1664) c0 = 640 + (n0 - 1536); else { c0 = 0; zero = true; }
            dst = wl + WO_WINB; ldK = 1024;
        } else {
            const int q = r - 4864, nt = q / 16, kt = q % 16;
            src = PIN[13] + (size_t)l * 1024 * 1024; ldN = 1024; k0 = kt * 64; n0 = nt * 64; c0 = n0;
            dst = wl + WO_WOUT; ldK = 1024;
        }
        cvt_tile(src, ldN, k0, c0, dst, ldK, n0, zero, tile);
    }
    {
        float* sc = (float*)smem;
        float* MOD = (float*)(wsp + OFF_MOD);
        for (int u = blockIdx.x; u < 288; u += gridDim.x) {
            const int l = u / 72, cch = u % 72;
            for (int idx = tid; idx < 32768; idx += 512) {
                const int b = idx >> 10, k = idx & 1023;
                const float c = b < 16 ? PIN[2][b * 1024 + k] : PIN[3][(b - 16) * 1024 + k];
                sc[k * 32 + b] = c / (1.0f + __expf(-c));
            }
            __syncthreads();
            const int cl = tid & 127, ks = tid >> 7, col = cch * 128 + cl;
            float acc[32];
#pragma unroll
            for (int b = 0; b < 32; ++b) acc[b] = 0.f;
            const float* wp = PIN[4] + ((size_t)l * 1024 + ks * 256) * 9216 + col;
            for (int k = 0; k < 256; ++k) {
                const float w = wp[(size_t)k * 9216];
                const f32x4* sp = (const f32x4*)(sc + (ks * 256 + k) * 32);
#pragma unroll
                for (int b4 = 0; b4 < 8; ++b4) { const f32x4 s = sp[b4]; acc[b4 * 4 + 0] += s[0] * w; acc[b4 * 4 + 1] += s[1] * w; acc[b4 * 4 + 2] += s[2] * w; acc[b4 * 4 + 3] += s[3] * w; }
            }
            __syncthreads();
            float* part = (float*)smem;
#pragma unroll
            for (int b = 0; b < 32; ++b) part[(ks * 32 + b) * 128 + cl] = acc[b];
            __syncthreads();
            for (int idx = tid; idx < 4096; idx += 512) {
                const int b = idx >> 7, c2 = idx & 127, cc = cch * 128 + c2;
                const float s = part[(0 * 32 + b) * 128 + c2] + part[(1 * 32 + b) * 128 + c2] + part[(2 * 32 + b) * 128 + c2] + part[(3 * 32 + b) * 128 + c2];
                MOD[((size_t)l * 32 + b) * 9216 + cc] = s + PIN[5][l * 9216 + cc];
            }
            __syncthreads();
        }
    }
    {
        float* zb = (float*)smem; float* ha = zb + 8 * 40; float* hb = ha + 8 * 64;
        float* H3 = (float*)(wsp + OFF_H3);
        for (int u = blockIdx.x; u < 384; u += gridDim.x) {
            const int l = u / 96, v = u % 96;
            const int Lsel = v >= 64, chunk = Lsel ? v - 64 : v, L = Lsel ? 2048 : 4096;
            const int lr = tid >> 6, j = tid & 63;
            const float fr = PIN[25][l * 64 + j];
            for (int it = 0; it < 8; ++it) {
                const int pos = chunk * 64 + it * 8 + lr;
                if (j < 33) {
                    const float tt = (float)pos / (float)(L - 1), w = (6.2831855f * (float)pos) / (float)L;
                    float val;
                    if (j == 0) val = tt;
                    else if (j <= 16) { const float fb = 1e-4f + (float)(j - 1) * 0.99999333f; val = cos_rad(fb * w); }
                    else { const float fb = 1e-4f + (float)(j - 17) * 0.99999333f; val = -sin_rad(fb * w); }
                    zb[lr * 40 + j] = val;
                }
                __syncthreads();
                float a = PIN[19][l * 64 + j];
                for (int i = 0; i < 33; ++i) a += zb[lr * 40 + i] * PIN[18][((size_t)l * 33 + i) * 64 + j];
                ha[lr * 64 + j] = sin_rad(fr * a);
                __syncthreads();
                a = PIN[21][l * 64 + j];
                for (int i = 0; i < 64; ++i) a += ha[lr * 64 + i] * PIN[20][((size_t)l * 64 + i) * 64 + j];
                hb[lr * 64 + j] = sin_rad(fr * a);
                __syncthreads();
                a = PIN[23][l * 64 + j];
                for (int i = 0; i < 64; ++i) a += hb[lr * 64 + i] * PIN[22][((size_t)l * 64 + i) * 64 + j];
                H3[((size_t)l * 6144 + (Lsel ? 4096 : 0) + pos) * 64 + j] = sin_rad(fr * a);
                __syncthreads();
            }
        }
    }
    {
        const double INV[8] = {1.0, 0.19392274474868576, 0.03760603093086393, 0.007292664737217109, 0.001414213562373095, 0.0002742481756762073, 5.318295896944988e-05, 1.031338537721246e-05};
        float2* rope = (float2*)(wsp + OFF_ROPE);
        for (int idx = blockIdx.x * 512 + tid; idx < 32768; idx += gridDim.x * 512) {
            const int pos = idx >> 3, i = idx & 7;
            double inv = INV[0];
#pragma unroll
            for (int q = 1; q < 8; ++q) inv = (i == q) ? INV[q] : inv;
            double r = (double)pos * inv * 0.15915494309189535; r -= rint(r);
            const float rf = (float)r;
            rope[idx] = make_float2(cos_rev(rf), sin_rev(rf));
        }
    }
}

__device__ __forceinline__ int PIX(int i) { return i + (i >> 5); }
constexpr int FFT_LDS_BYTES = (8192 + 256) * 8;
__device__ __forceinline__ float2 cmul(float2 a, float2 b) { return make_float2(a.x * b.x - a.y * b.y, a.x * b.y + a.y * b.x); }
__device__ __forceinline__ float2 cmulc(float2 a, float2 b) { return make_float2(a.x * b.x + a.y * b.y, a.y * b.x - a.x * b.y); }
#define ROOT16X(k) ((k) == 0 ? 1.0f : (k) == 1 ? 0.92387953251f : (k) == 2 ? 0.70710678119f : (k) == 3 ? 0.38268343237f : (k) == 4 ? 0.0f : (k) == 5 ? -0.38268343237f : (k) == 6 ? -0.70710678119f : -0.92387953251f)
#define ROOT16Y(k) ((k) == 0 ? 0.0f : (k) == 1 ? -0.38268343237f : (k) == 2 ? -0.70710678119f : (k) == 3 ? -0.92387953251f : (k) == 4 ? -1.0f : (k) == 5 ? -0.92387953251f : (k) == 6 ? -0.70710678119f : -0.38268343237f)
constexpr int FFT_BUF_STRIDE = 8192 + 256;
template <int LOGN, int S, int R, bool INV, int NB>
__device__ __forceinline__ void fft_pass(float2* buf, int tid) {
    constexpr int RR = 1 << R, N = 1 << LOGN, lgD = LOGN - S - R, D = 1 << lgD, ngroups = N >> R;
    static_assert(D >= 32 || D == 16 || D == 2 || D == 1, "padded-index shortcut");
    for (int gidx = tid; gidx < ngroups; gidx += 512) {
        const int lo = gidx & (D - 1), hi = gidx >> lgD, base = (hi << (LOGN - S)) + lo, pb = PIX(base);
        const float fr = (float)lo * (1.0f / (float)(D << R));
        float2 wq[R];
        wq[0] = make_float2(cos_rev(fr), -sin_rev(fr));
#pragma unroll
        for (int q = 1; q < R; ++q) wq[q] = cmul(wq[q - 1], wq[q - 1]);
        float2 tw[RR];
#pragma unroll
        for (int q = 0; q < R; ++q) {
            const int h = 1 << (R - 1 - q);
#pragma unroll
            for (int k = 0; k < h; ++k) { const int ri = k << (4 - R + q); tw[RR - 2 * h + k] = cmul(wq[q], make_float2(ROOT16X(ri), ROOT16Y(ri))); }
        }
#pragma unroll
        for (int nb = 0; nb < NB; ++nb) {
            float2* bb = buf + nb * FFT_BUF_STRIDE;
            float2 v[RR];
#pragma unroll
            for (int m = 0; m < RR; ++m) v[m] = bb[pb + m * D + ((m * D) >> 5)];
#pragma unroll
            for (int qq = 0; qq < R; ++qq) {
                const int q = INV ? (R - 1 - qq) : qq;
                const int h = 1 << (R - 1 - q);
#pragma unroll
                for (int k = 0; k < h; ++k) {
                    const float2 t_w = tw[RR - 2 * h + k];
#pragma unroll
                    for (int blk = 0; blk < RR; blk += 2 * h) {
                        const int m0 = blk + k, m1 = m0 + h;
                        const float2 a = v[m0], b = v[m1];
                        if (!INV) { v[m0] = make_float2(a.x + b.x, a.y + b.y); v[m1] = cmul(make_float2(a.x - b.x, a.y - b.y), t_w); }
                        else { const float2 t = cmulc(b, t_w); v[m0] = make_float2(a.x + t.x, a.y + t.y); v[m1] = make_float2(a.x - t.x, a.y - t.y); }
                    }
                }
            }
#pragma unroll
            for (int m = 0; m < RR; ++m) bb[pb + m * D + ((m * D) >> 5)] = v[m];
        }
    }
    __syncthreads();
}
template <int LOGN, int NB> __device__ __forceinline__ void fft_fwd(float2* buf, int tid) {
    fft_pass<LOGN, 0, 4, false, NB>(buf, tid); fft_pass<LOGN, 4, 4, false, NB>(buf, tid); fft_pass<LOGN, 8, 4, false, NB>(buf, tid);
    if constexpr (LOGN == 13) fft_pass<LOGN, 12, 1, false, NB>(buf, tid);
}
template <int LOGN, int NB> __device__ __forceinline__ void fft_inv(float2* buf, int tid) {
    if constexpr (LOGN == 13) fft_pass<LOGN, 12, 1, true, NB>(buf, tid);
    fft_pass<LOGN, 8, 4, true, NB>(buf, tid); fft_pass<LOGN, 4, 4, true, NB>(buf, tid); fft_pass<LOGN, 0, 4, true, NB>(buf, tid);
}

template <int LOGN>
__device__ __forceinline__ void filt_unit(const Params& p, int l, int cp, unsigned char* smem, int zl, unsigned char* wsp) {
    const int tid = ltid();
    float2* buf = (float2*)smem; float* w4s = (float*)(smem + 69632);
    const float* H3 = (const float*)(wsp + OFF_H3);
    float2* KF = (float2*)(wsp + OFF_KF);
    {
        constexpr int Lsel = (LOGN == 12), L = 1 << (LOGN - 1), logN = LOGN, N = 2 * L;
        if (tid < 256) { const int i = tid >> 2, q = tid & 3; w4s[tid] = PIN[24][((size_t)l * 64 + i) * 1024 + (q >> 1) * 512 + 2 * cp + (q & 1)]; }
        const float d00 = fabsf(PIN[26][(l * 2 + 0) * 512 + 2 * cp]), d01 = fabsf(PIN[26][(l * 2 + 0) * 512 + 2 * cp + 1]);
        const float d10 = fabsf(PIN[26][(l * 2 + 1) * 512 + 2 * cp]), d11 = fabsf(PIN[26][(l * 2 + 1) * 512 + 2 * cp + 1]);
        __syncthreads();
#pragma nounroll
        for (int pos = tid; pos < L; pos += 512) {
            const f32x4* hrow = (const f32x4*)(H3 + ((size_t)l * 6144 + (Lsel ? 4096 : 0) + pos) * 64);
            float a0 = 0.f, a1 = 0.f, a2 = 0.f, a3 = 0.f;
#pragma unroll
            for (int i4 = 0; i4 < 16; ++i4) {
                const f32x4 h = hrow[i4];
#pragma unroll
                for (int e = 0; e < 4; ++e) { const f32x4 wv = *(const f32x4*)(w4s + (i4 * 4 + e) * 4); a0 += h[e] * wv[0]; a1 += h[e] * wv[1]; a2 += h[e] * wv[2]; a3 += h[e] * wv[3]; }
            }
            const float tt = (float)pos / (float)(L - 1);
            const float hf1 = a0 * __expf(-tt * d00), hf2 = a1 * __expf(-tt * d01), hb1 = a2 * __expf(-tt * d10), hb2 = a3 * __expf(-tt * d11);
            if (pos == 0) { buf[0] = make_float2(hf1 + hb1, hf2 + hb2); buf[PIX(L)] = make_float2(0.f, 0.f); }
            else { buf[PIX(pos)] = make_float2(hf1, hf2); buf[PIX(N - pos)] = make_float2(hb1, hb2); }
        }
        __syncthreads();
        fft_fwd<LOGN, 1>(buf, tid);
        const float sc = 0.25f / (float)N;
        float2* K1 = KF + (size_t)l * KF_LAYER + (Lsel ? (size_t)512 * KS4 + (size_t)(2 * cp) * KS2 : (size_t)(2 * cp) * KS4);
        float2* K2 = K1 + (Lsel ? KS2 : KS4);
#pragma nounroll
        for (int k = tid; k <= L; k += 512) {
            const int pa = (int)(__brev((unsigned)k) >> (32 - logN)), pb = (int)(__brev((unsigned)((N - k) & (N - 1))) >> (32 - logN));
            const float2 a = buf[PIX(pa)], b = buf[PIX(pb)];
            K1[k] = make_float2((a.x + b.x) * sc, (a.y - b.y) * sc);
            K2[k] = make_float2((a.y + b.y) * sc, -(a.x - b.x) * sc);
        }
        __syncthreads();
    }
}

__device__ __forceinline__ void phase0b(const Params& p, unsigned char* smem) {
    const int zl = launder0(); unsigned char* const wsp = lptr(p.ws); float* const xp = lptr(p.X); (void)xp;
    const int tid = ltid(), lane = tid & 63, w = tid >> 6;
    float2* buf = (float2*)smem; float* w4s = (float*)(smem + 69632);
    const float* H3 = (const float*)(wsp + OFF_H3);
    float2* KF = (float2*)(wsp + OFF_KF);
    for (int v = blockIdx.x; v < 2048; v += gridDim.x) {
        const int l = v >> 9, ww = v & 511, cp = ww & 255;
        if (ww >> 8) filt_unit<12>(p, l, cp, smem, zl, wsp); else filt_unit<13>(p, l, cp, smem, zl, wsp);
    }
    {
        const float* MOD = (const float*)(wsp + OFF_MOD);
        bf16_t* H = (bf16_t*)(wsp + OFF_H);
        for (int row = blockIdx.x * 8 + w; row < MTOT; row += gridDim.x * 8) {
            const float* src = row < 65536 ? PIN[0] + (size_t)row * 1024 : PIN[1] + (size_t)(row - 65536) * 1024;
            const float* md = MOD + (size_t)row_bidx(row) * 9216;
#pragma unroll
            for (int i = 0; i < 4; ++i) {
                const int col = i * 256 + lane * 4;
                const f32x4 v = *(const f32x4*)(src + col), sh = *(const f32x4*)(md + col), scl = *(const f32x4*)(md + 1024 + col);
                *(f32x4*)(xp + (size_t)row * 1024 + col) = v;
                const f32x4 h = v * (scl + 1.0f) + sh;
                u32x2 pk; pk[0] = pk2(h[0], h[1]); pk[1] = pk2(h[2], h[3]);
                *(u32x2*)(H + (size_t)row * 1024 + col) = pk;
            }
        }
    }
}

__device__ __forceinline__ void lnmod_phase(unsigned char* wsp, float* xp, const float* __restrict__ g, const float* __restrict__ bb, const float* __restrict__ modbase, bool write_x) {
    const int tid = ltid(), lane = tid & 63, w = tid >> 6;
    bf16_t* H = (bf16_t*)(wsp + OFF_H);
    float2* stats = (float2*)(wsp + OFF_STATS);
    constexpr int NR = 4;
    for (int rp = blockIdx.x * 8 + w; rp < MTOT / NR; rp += gridDim.x * 8) {
        const int row = rp * NR;
        float* xr = xp + (size_t)row * 1024;
        f32x4 v[NR][4];
#pragma unroll
        for (int r2 = 0; r2 < NR; ++r2)
#pragma unroll
            for (int i = 0; i < 4; ++i) v[r2][i] = *(const f32x4*)(xr + r2 * 1024 + i * 256 + lane * 4);
        float mean[NR], rstd[NR];
#pragma unroll
        for (int r2 = 0; r2 < NR; ++r2) {
            float s = 0.f;
#pragma unroll
            for (int i = 0; i < 4; ++i) s += v[r2][i][0] + v[r2][i][1] + v[r2][i][2] + v[r2][i][3];
            mean[r2] = s;
        }
#pragma unroll
        for (int o = 1; o < 64; o <<= 1)
#pragma unroll
            for (int r2 = 0; r2 < NR; ++r2) mean[r2] += __shfl_xor(mean[r2], o);
#pragma unroll
        for (int r2 = 0; r2 < NR; ++r2) {
            mean[r2] *= (1.0f / 1024.0f);
            float q = 0.f;
#pragma unroll
            for (int i = 0; i < 4; ++i) { const f32x4 d = v[r2][i] - mean[r2]; q += d[0] * d[0] + d[1] * d[1] + d[2] * d[2] + d[3] * d[3]; }
            rstd[r2] = q;
        }
#pragma unroll
        for (int o = 1; o < 64; o <<= 1)
#pragma unroll
            for (int r2 = 0; r2 < NR; ++r2) rstd[r2] += __shfl_xor(rstd[r2], o);
#pragma unroll
        for (int r2 = 0; r2 < NR; ++r2) {
            rstd[r2] = rsqrtf(rstd[r2] * (1.0f / 1024.0f) + 1e-5f);
            if (lane == 0) stats[row + r2] = make_float2(mean[r2], rstd[r2]);
        }
        const float* md = modbase ? modbase + (size_t)row_bidx(row) * 9216 : nullptr;
#pragma unroll
        for (int i = 0; i < 4; ++i) {
            const int col = i * 256 + lane * 4;
            const f32x4 gg = *(const f32x4*)(g + col), be = *(const f32x4*)(bb + col);
            f32x4 sh = {0.f, 0.f, 0.f, 0.f}, scl = {0.f, 0.f, 0.f, 0.f};
            if (md) { sh = *(const f32x4*)(md + col); scl = *(const f32x4*)(md + 1024 + col); }
#pragma unroll
            for (int r2 = 0; r2 < NR; ++r2) {
                const f32x4 xn = (v[r2][i] - mean[r2]) * rstd[r2] * gg + be;
                if (write_x) *(f32x4*)(xr + r2 * 1024 + col) = xn;
                if (md) {
                    const f32x4 h = xn * (scl + 1.0f) + sh;
                    u32x2 pk; pk[0] = pk2(h[0], h[1]); pk[1] = pk2(h[2], h[3]);
                    *(u32x2*)(H + (size_t)(row + r2) * 1024 + col) = pk;
                }
            }
        }
    }
}

__device__ __forceinline__ u32x4 rope_apply(u32x4 mine, u32x4 other, const float2* __restrict__ tab, int second) {
    u32x4 out;
#pragma unroll
    for (int q = 0; q < 4; ++q) {
        const f32x4 cs = *(const f32x4*)(tab + 2 * q);
        const float m0 = bf_lo(mine[q]), m1 = bf_hi(mine[q]), o0 = bf_lo(other[q]), o1 = bf_hi(other[q]);
        const float r0 = second ? m0 * cs[0] + o0 * cs[1] : m0 * cs[0] - o0 * cs[1];
        const float r1 = second ? m1 * cs[2] + o1 * cs[3] : m1 * cs[2] - o1 * cs[3];
        out[q] = pk2(r0, r1);
    }
    return out;
}

__device__ __forceinline__ void attn_unit(const Params& p, int l, int ua, unsigned char* smem) {
    const int zl = launder0(); unsigned char* const wsp = lptr(p.ws); float* const xp = lptr(p.X); (void)xp;
    const int tid = ltid(), lane = tid & 63, w = tid >> 6;
    const int qb = ua >> 1, g = ua & 1;
    int blk, nb;
    if (qb < 512) { blk = qb & 31; nb = 32; } else { blk = (qb - 512) & 15; nb = 16; }
    const int row0 = qb * 128, pos0 = blk * 128;
    const bool hasPrev = blk > 0, hasNext = blk < nb - 1;
    const bf16_t* ZA = (const bf16_t*)(wsp + OFF_ZA);
    const bf16_t* ZT = (const bf16_t*)(wsp + OFF_ZT);
    bf16_t* A2 = (bf16_t*)(wsp + OFF_H);
    const float2* rope = (const float2*)(wsp + OFF_ROPE);
    unsigned char* Ks = smem;
    unsigned char* Vs = smem + 55296;
#pragma unroll
    for (int i = 0; i < 6; ++i) {
        const int idx = tid + 512 * i, kb = idx >> 3, part = idx & 7, b3 = kb >> 7;
        const bool valid = (b3 == 1) || (b3 == 0 && hasPrev) || (b3 == 2 && hasNext);
        u32x4 v = {0u, 0u, 0u, 0u};
        if (valid) {
            const bf16_t* src = ZA + (size_t)(row0 - 128 + kb) * 768 + 512 + g * 64;
            v = *(const u32x4*)(src + part * 8);
            if (part < 2) { const u32x4 o = *(const u32x4*)(src + (part ^ 1) * 8); v = rope_apply(v, o, rope + (size_t)(pos0 - 128 + kb) * 8, part); }
        }
        *(u32x4*)(Ks + kb * 144 + part * 16) = v;
    }
#pragma unroll
    for (int i = 0; i < 6; ++i) {
        const int idx = tid + 512 * i, d = idx / 48, part = idx % 48, kb0 = part * 8, b3 = kb0 >> 7;
        const bool valid = (b3 == 1) || (b3 == 0 && hasPrev) || (b3 == 2 && hasNext);
        u32x4 v = {0u, 0u, 0u, 0u};
        if (valid) v = *(const u32x4*)(ZT + (size_t)(1536 + g * 64 + d) * MTOT + row0 - 128 + kb0);
        *(u32x4*)(Vs + d * 784 + part * 16) = v;
    }
    __syncthreads();
    const int hh = w >> 1, head = g * 4 + hh;
    const float sinkv = PIN[14][l * 8 + head];
    const int r = lane & 31, h = lane >> 5;
    for (int qt = 0; qt < 2; ++qt) {
        const int qi = (w & 1) * 2 + qt;
        const int qrow = row0 + 32 * qi + r, qpos = pos0 + 32 * qi + r;
        const bf16_t* qsrc = ZA + (size_t)qrow * 768 + head * 64;
        bf16x8 qf[4];
#pragma unroll
        for (int s = 0; s < 4; ++s) {
            u32x4 v = *(const u32x4*)(qsrc + 16 * s + 8 * h);
            if (s == 0) { const u32x4 o = *(const u32x4*)(qsrc + 8 * (1 - h)); v = rope_apply(v, o, rope + (size_t)qpos * 8, h); }
#pragma unroll
            for (int q = 0; q < 4; ++q) v[q] = pk2(bf_lo(v[q]) * 0.125f, bf_hi(v[q]) * 0.125f);
            qf[s] = __builtin_bit_cast(bf16x8, v);
        }
        float mrun = sinkv, lsum = 1.0f;
        f32x16 O[2];
#pragma unroll
        for (int dt = 0; dt < 2; ++dt)
#pragma unroll
            for (int e = 0; e < 16; ++e) O[dt][e] = 0.f;
#pragma nounroll
        for (int ch = 0; ch < 3; ++ch) {
            f32x16 S[3];
#pragma unroll
            for (int c = 0; c < 3; ++c) {
#pragma unroll
                for (int e = 0; e < 16; ++e) S[c][e] = 0.f;
                const unsigned char* kp = Ks + (32 * (qi + 3 * ch + c) + r) * 144 + h * 16;
#pragma unroll
                for (int s = 0; s < 4; ++s) { const bf16x8 kf = *(const bf16x8*)(kp + s * 32); S[c] = __builtin_amdgcn_mfma_f32_32x32x16_bf16(kf, qf[s], S[c], 0, 0, 0); }
            }
            float cmax = -1e30f;
#pragma unroll
            for (int c = 0; c < 3; ++c) {
                const int tp = 3 * ch + c, b3 = (qi + tp) >> 2;
                const bool tv = (b3 == 1) || (b3 == 0 && hasPrev) || (b3 == 2 && hasNext);
#pragma unroll
                for (int e = 0; e < 16; ++e) {
                    const int kk = (e & 3) + 8 * (e >> 2) + 4 * h;
                    bool ok = tv;
                    if (c == 0) ok = ok && (tp != 0 || kk >= r);
                    if (c == 2) ok = ok && (tp != 8 || kk <= r);
                    const float sv = ok ? S[c][e] : -1e30f;
                    S[c][e] = sv; cmax = fmaxf(cmax, sv);
                }
            }
            cmax = fmaxf(cmax, __shfl_xor(cmax, 32));
            const float mnew = fmaxf(mrun, cmax), scl = __expf(mrun - mnew);
            mrun = mnew;
            float psum = 0.f;
#pragma unroll
            for (int c = 0; c < 3; ++c)
#pragma unroll
                for (int e = 0; e < 16; ++e) { const float pv = __expf(S[c][e] - mnew); S[c][e] = pv; psum += pv; }
            psum += __shfl_xor(psum, 32);
            lsum = lsum * scl + psum;
#pragma unroll
            for (int dt = 0; dt < 2; ++dt)
#pragma unroll
                for (int e = 0; e < 16; ++e) O[dt][e] *= scl;
#pragma unroll
            for (int c = 0; c < 3; ++c)
#pragma unroll
                for (int s2 = 0; s2 < 2; ++s2) {
                    u32x4 pp; pp[0] = pk2(S[c][8 * s2 + 0], S[c][8 * s2 + 1]); pp[1] = pk2(S[c][8 * s2 + 2], S[c][8 * s2 + 3]); pp[2] = pk2(S[c][8 * s2 + 4], S[c][8 * s2 + 5]); pp[3] = pk2(S[c][8 * s2 + 6], S[c][8 * s2 + 7]);
                    const bf16x8 pf = __builtin_bit_cast(bf16x8, pp);
#pragma unroll
                    for (int dt = 0; dt < 2; ++dt) {
                        const unsigned char* vp = Vs + (32 * dt + r) * 784 + (32 * (qi + 3 * ch + c) + 16 * s2 + 4 * h) * 2;
                        const u32x2 lo = *(const u32x2*)vp, hi = *(const u32x2*)(vp + 16);
                        u32x4 vv; vv[0] = lo[0]; vv[1] = lo[1]; vv[2] = hi[0]; vv[3] = hi[1];
                        O[dt] = __builtin_amdgcn_mfma_f32_32x32x16_bf16(__builtin_bit_cast(bf16x8, vv), pf, O[dt], 0, 0, 0);
                    }
                }
        }
        const float inv = 1.0f / lsum;
        bf16_t* op = A2 + (size_t)qrow * 1024 + head * 64;
#pragma unroll
        for (int dt = 0; dt < 2; ++dt)
#pragma unroll
            for (int gq = 0; gq < 4; ++gq) {
                u32x2 o; o[0] = pk2(O[dt][4 * gq + 0] * inv, O[dt][4 * gq + 1] * inv); o[1] = pk2(O[dt][4 * gq + 2] * inv, O[dt][4 * gq + 3] * inv);
                *(u32x2*)(op + 32 * dt + 8 * gq + 4 * h) = o;
            }
    }
    __syncthreads();
}

template <int LOGN>
__device__ __forceinline__ void hyena_unit(const Params& p, int l, int hu, unsigned char* smem, bool dry = false) {
    const int zl = launder0(); unsigned char* const wsp = lptr(p.ws);
    const int tid = ltid();
    constexpr int L = 1 << (LOGN - 1), logN = LOGN, N = 2 * L;
    const int bidx = (LOGN == 13 ? 0 : 16) + (hu >> 7), cq = hu & 127;
    const size_t rb = bidx < 16 ? (size_t)bidx * 4096 : 65536 + (size_t)(bidx - 16) * 2048;
    float2* buf = (float2*)smem;
    bf16_t* ZT = (bf16_t*)(wsp + OFF_ZT);
    const float* cw = PIN[16] + (size_t)l * 3 * 1536; const float* cb = PIN[17] + (size_t)l * 1536;
    const int t8 = tid * 8; const bool act = t8 < L;
    float u[2][2][8], x0c[2][2][8];
    if (act) {
#pragma unroll
        for (int pp = 0; pp < 2; ++pp) {
            const int c1 = 4 * cq + 2 * pp;
#pragma unroll
            for (int cc = 0; cc < 2; ++cc) {
                float cv[3][8];
#pragma unroll
                for (int gi = 0; gi < 3; ++gi) {
                    const int col = gi * 512 + c1 + cc;
                    const bf16_t* src = ZT + (size_t)col * MTOT + rb + t8;
                    const u32x4 raw = *(const u32x4*)src;
                    float in[10];
                    in[0] = t8 > 0 ? bf2f(src[-1]) : 0.f;
                    in[9] = (t8 + 8 < L) ? bf2f(src[8]) : 0.f;
#pragma unroll
                    for (int q = 0; q < 4; ++q) { in[1 + 2 * q] = bf_lo(raw[q]); in[2 + 2 * q] = bf_hi(raw[q]); }
                    const float w0 = cw[col], w1 = cw[1536 + col], w2 = cw[3072 + col], bsv = cb[col];
#pragma unroll
                    for (int j = 0; j < 8; ++j) cv[gi][j] = w0 * in[j] + w1 * in[j + 1] + w2 * in[j + 2] + bsv;
                }
#pragma unroll
                for (int j = 0; j < 8; ++j) { u[pp][cc][j] = cv[2][j] * cv[1][j]; x0c[pp][cc][j] = cv[0][j]; }
            }
            float2* bb = buf + pp * FFT_BUF_STRIDE;
#pragma unroll
            for (int j = 0; j < 8; ++j) { bb[PIX(t8 + j)] = make_float2(u[pp][0][j], u[pp][1][j]); bb[PIX(L + t8 + j)] = make_float2(0.f, 0.f); }
        }
    }
    __syncthreads();
    fft_fwd<LOGN, 2>(buf, tid);
    {
        const float2* KF = (const float2*)(wsp + OFF_KF);
#pragma unroll
        for (int pp = 0; pp < 2; ++pp) {
            const int c1 = 4 * cq + 2 * pp;
            const float2* K1 = KF + (size_t)l * KF_LAYER + (bidx < 16 ? (size_t)c1 * KS4 : (size_t)512 * KS4 + (size_t)c1 * KS2);
            const float2* K2 = K1 + (bidx < 16 ? KS4 : KS2);
            float2* bb = buf + pp * FFT_BUF_STRIDE;
#pragma unroll
            for (int i = 0; i < 9; ++i) {
                const int k = tid + 512 * i; if (k > L) continue;
                const int pa = (int)(__brev((unsigned)k) >> (32 - logN)), pb = (int)(__brev((unsigned)((N - k) & (N - 1))) >> (32 - logN));
                const float2 a = bb[PIX(pa)], b = bb[PIX(pb)];
                const float u1x = a.x + b.x, u1y = a.y - b.y, u2x = a.y + b.y, u2y = b.x - a.x;
                const float2 k1 = K1[k], k2 = K2[k];
                const float p1x = u1x * k1.x - u1y * k1.y, p1y = u1x * k1.y + u1y * k1.x;
                const float p2x = u2x * k2.x - u2y * k2.y, p2y = u2x * k2.y + u2y * k2.x;
                bb[PIX(pa)] = make_float2(p1x - p2y, p1y + p2x);
                if (pb != pa) bb[PIX(pb)] = make_float2(p1x + p2y, p2x - p1y);
            }
        }
    }
    __syncthreads();
    fft_inv<LOGN, 2>(buf, tid);
    if (act) {
#pragma unroll
        for (int pp = 0; pp < 2; ++pp) {
            const int c1 = 4 * cq + 2 * pp;
            const float2* bb = buf + pp * FFT_BUF_STRIDE;
#pragma unroll
            for (int cc = 0; cc < 2; ++cc) {
                const float bias = PIN[27][l * 512 + c1 + cc];
                float o[8];
#pragma unroll
                for (int j = 0; j < 8; ++j) { const float2 y = bb[PIX(t8 + j)]; o[j] = ((cc ? y.y : y.x) + u[pp][cc][j] * bias) * x0c[pp][cc][j]; }
                u32x4 pk; pk[0] = pk2(o[0], o[1]); pk[1] = pk2(o[2], o[3]); pk[2] = pk2(o[4], o[5]); pk[3] = pk2(o[6], o[7]);
                if (!dry) *(u32x4*)(ZT + (size_t)(c1 + cc) * MTOT + rb + t8) = pk;
            }
        }
    }
    __syncthreads();
}

__device__ __forceinline__ void rms_unit(const Params& p, int l, int rc, unsigned char* smem) {
    const int zl = launder0(); unsigned char* const wsp = lptr(p.ws); float* const xp = lptr(p.X); (void)xp;
    const int tid = ltid(), lane = tid & 63, w = tid >> 6;
    const int row0 = rc * 64;
    bf16_t* A2 = (bf16_t*)(wsp + OFF_H);
    const bf16_t* ZT = (const bf16_t*)(wsp + OFF_ZT);
    const float* gn = PIN[15] + (size_t)l * 1024;
    {
        const f32x4 g0 = *(const f32x4*)(gn + lane * 8), g1 = *(const f32x4*)(gn + lane * 8 + 4);
        bf16_t* ap = A2 + (size_t)(row0 + w * 8) * 1024 + lane * 8;
        u32x4 va[8]; float ss[8];
#pragma unroll
        for (int rr = 0; rr < 8; ++rr) va[rr] = *(const u32x4*)(ap + (size_t)rr * 1024);
#pragma unroll
        for (int rr = 0; rr < 8; ++rr) {
            float a = 0.f;
#pragma unroll
            for (int q = 0; q < 4; ++q) { const float lo = bf_lo(va[rr][q]), hi = bf_hi(va[rr][q]); a += lo * lo + hi * hi; }
            ss[rr] = a;
        }
#pragma unroll
        for (int o = 1; o < 64; o <<= 1)
#pragma unroll
            for (int rr = 0; rr < 8; ++rr) ss[rr] += __shfl_xor(ss[rr], o);
#pragma unroll
        for (int rr = 0; rr < 8; ++rr) {
            const float rstd = rsqrtf(ss[rr] * (1.0f / 512.0f) + 1e-6f);
            u32x4 pk;
            pk[0] = pk2(bf_lo(va[rr][0]) * rstd * g0[0], bf_hi(va[rr][0]) * rstd * g0[1]); pk[1] = pk2(bf_lo(va[rr][1]) * rstd * g0[2], bf_hi(va[rr][1]) * rstd * g0[3]);
            pk[2] = pk2(bf_lo(va[rr][2]) * rstd * g1[0], bf_hi(va[rr][2]) * rstd * g1[1]); pk[3] = pk2(bf_lo(va[rr][3]) * rstd * g1[2], bf_hi(va[rr][3]) * rstd * g1[3]);
            *(u32x4*)(ap + (size_t)rr * 1024) = pk;
        }
    }
    bf16_t* T = (bf16_t*)smem;
    {
        const int c = tid;
        u32x4 vv[8];
#pragma unroll
        for (int q = 0; q < 8; ++q) vv[q] = *(const u32x4*)(ZT + (size_t)c * MTOT + row0 + q * 8);
#pragma unroll
        for (int q = 0; q < 8; ++q)
#pragma unroll
            for (int e = 0; e < 4; ++e) { T[(q * 8 + 2 * e) * 520 + c] = (bf16_t)(vv[q][e] & 0xffffu); T[(q * 8 + 2 * e + 1) * 520 + c] = (bf16_t)(vv[q][e] >> 16); }
    }
    __syncthreads();
    {
        const f32x4 g0 = *(const f32x4*)(gn + 512 + lane * 8), g1 = *(const f32x4*)(gn + 512 + lane * 8 + 4);
        u32x4 va[8]; float ss[8];
#pragma unroll
        for (int rr = 0; rr < 8; ++rr) va[rr] = *(const u32x4*)(T + (w * 8 + rr) * 520 + lane * 8);
#pragma unroll
        for (int rr = 0; rr < 8; ++rr) {
            float a = 0.f;
#pragma unroll
            for (int q = 0; q < 4; ++q) { const float lo = bf_lo(va[rr][q]), hi = bf_hi(va[rr][q]); a += lo * lo + hi * hi; }
            ss[rr] = a;
        }
#pragma unroll
        for (int o = 1; o < 64; o <<= 1)
#pragma unroll
            for (int rr = 0; rr < 8; ++rr) ss[rr] += __shfl_xor(ss[rr], o);
#pragma unroll
        for (int rr = 0; rr < 8; ++rr) {
            const float rstd = rsqrtf(ss[rr] * (1.0f / 512.0f) + 1e-6f);
            u32x4 pk;
            pk[0] = pk2(bf_lo(va[rr][0]) * rstd * g0[0], bf_hi(va[rr][0]) * rstd * g0[1]); pk[1] = pk2(bf_lo(va[rr][1]) * rstd * g0[2], bf_hi(va[rr][1]) * rstd * g0[3]);
            pk[2] = pk2(bf_lo(va[rr][2]) * rstd * g1[0], bf_hi(va[rr][2]) * rstd * g1[1]); pk[3] = pk2(bf_lo(va[rr][3]) * rstd * g1[2], bf_hi(va[rr][3]) * rstd * g1[3]);
            *(u32x4*)(A2 + (size_t)(row0 + w * 8 + rr) * 1024 + 512 + lane * 8) = pk;
        }
    }
    __syncthreads();
}

#define LAS __attribute__((address_space(3)))
#define XB_TMO      128
#define XB_XCNT(j)  (256  + 64 * (j))
#define XB_XSUB(j)  (1280 + 64 * (j))
#define XB_XGEN(j)  (2304 + 64 * (j))
#define XB_TOP      3328
#define XB_TOPGEN   3392
#define XCD_BAR_WORDS 3456
#define XB_SPIN_CAP (1u << 18)

__device__ __forceinline__ unsigned xb_ld(unsigned* p)              { return __hip_atomic_load(p, __ATOMIC_RELAXED, __HIP_MEMORY_SCOPE_AGENT); }
__device__ __forceinline__ unsigned xb_add(unsigned* p, unsigned v) { return __hip_atomic_fetch_add(p, v, __ATOMIC_RELAXED, __HIP_MEMORY_SCOPE_AGENT); }
__device__ __forceinline__ unsigned xb_xcc_id() { return (unsigned)__builtin_amdgcn_s_getreg((3 << 11) | 20) & 0xFu; }
#define XB_SPIN(cond, bar) do { unsigned _sp = 0; while (cond) { __builtin_amdgcn_s_sleep(1); \
    if ((++_sp & 255u) == 0u) { if (xb_ld(&(bar)[XB_TMO])) break; if (_sp > XB_SPIN_CAP) { atomicAdd(&(bar)[XB_TMO], 1u); break; } } } } while (0)

struct XcdBarrier {
    unsigned* bar; unsigned x;
    volatile LAS unsigned* st;
};

__device__ __forceinline__ XcdBarrier xcd_barrier_post(unsigned* bar, volatile LAS unsigned* st) {
    XcdBarrier b; b.bar = bar; b.x = xb_xcc_id(); b.st = st;
    if (threadIdx.x == 0) (void)xb_add(&bar[XB_XCNT(b.x)], 1u);
    return b;
}
__device__ __forceinline__ void xcd_barrier_complete(unsigned* bar, unsigned x, unsigned& nloc, unsigned& nx) {
    const unsigned G = gridDim.x * gridDim.y * gridDim.z;
    unsigned sum, cnt, mine, sp = 0u;
    for (;;) {
        sum = 0u; cnt = 0u; mine = 0u;
#pragma unroll
        for (unsigned j = 0; j < 16; ++j) { const unsigned c = xb_ld(&bar[XB_XCNT(j)]); sum += c; cnt += (c > 0u) ? 1u : 0u; mine = (j == x) ? c : mine; }
        if (sum == G) break;
        __builtin_amdgcn_s_sleep(1);
        if ((++sp & 255u) == 0u) { if (xb_ld(&bar[XB_TMO])) break; if (sp > XB_SPIN_CAP) { atomicAdd(&bar[XB_TMO], 1u); break; } }
    }
    nloc = mine > 0u ? mine : 1u; nx = cnt > 0u ? cnt : 1u;
}

__device__ __forceinline__ void xcd_barrier(const XcdBarrier& b) {
    asm volatile("s_waitcnt vmcnt(0)" ::: "memory");
    __syncthreads();
    if (threadIdx.x == 0) {
        unsigned* bar = b.bar;
        __builtin_amdgcn_s_waitcnt(0);
        unsigned nloc = b.st[0], nx = b.st[1];
        if (nloc == 0u) { xcd_barrier_complete(bar, b.x, nloc, nx); b.st[0] = nloc; b.st[1] = nx; }
        const unsigned old = xb_add(&bar[XB_XSUB(b.x)], 1u);
        const unsigned gen = old / nloc;
        if (old + 1u == (gen + 1u) * nloc) {
            __builtin_amdgcn_fence(__ATOMIC_RELEASE, "agent");
            asm volatile("s_waitcnt vmcnt(0)" ::: "memory");
            const unsigned og = xb_add(&bar[XB_TOP], 1u);
            const unsigned tg = og / nx;
            if (og + 1u == (tg + 1u) * nx) xb_add(&bar[XB_TOPGEN], 1u);
            else XB_SPIN(xb_ld(&bar[XB_TOPGEN]) == tg, bar);
            __builtin_amdgcn_fence(__ATOMIC_ACQUIRE, "agent");
            xb_add(&bar[XB_XGEN(b.x)], 1u);
            asm volatile("s_waitcnt vmcnt(0)" ::: "memory");
        } else {
            XB_SPIN(xb_ld(&bar[XB_XGEN(b.x)]) == gen, bar);
            __builtin_amdgcn_fence(__ATOMIC_ACQUIRE, "agent");
            asm volatile("s_waitcnt vmcnt(0)" ::: "memory");
        }
    }
    __syncthreads();
}

__global__ void __launch_bounds__(512) hymba_fwd(Params p) {
    extern __shared__ __attribute__((aligned(16))) unsigned char smem[];
    cg::grid_group grid = cg::this_grid();
    volatile LAS unsigned* bst = (volatile LAS unsigned*)(smem + 135168 + 512);
    if (threadIdx.x < 2) bst[threadIdx.x] = 0u;
    __syncthreads();
    XcdBarrier xbar = xcd_barrier_post((unsigned*)(p.ws + OFF_BAR), bst);
    PG8_LAS unsigned char* lds = (PG8_LAS unsigned char*)smem;
    const int G = gridDim.x, wg = blockIdx.x;
    for (int ph = p.ph_lo; ph < p.ph_hi; ++ph) {
        const int zl = launder0(); unsigned char* const wsp = lptr(p.ws); float* const xp = lptr(p.X);
        bf16_t* Hb = (bf16_t*)(wsp + OFF_H); bf16_t* ACT = (bf16_t*)(wsp + OFF_ACT); float* MOD = (float*)(wsp + OFF_MOD);
#ifdef PROBE_P0
        if (ph == 0) { phase0a(p, smem); __syncthreads(); }
        if (ph == 1) { phase0b(p, smem); __syncthreads(); }
#endif
        if (EN_P0 && ph == 0) phase0a(p, smem);
        else if (EN_P1 && ph == 1) phase0b(p, smem);
        else {
            const int l = (ph - 2) / 11, s = (ph - 2) % 11;
            const bf16_t* wl = (const bf16_t*)(wsp + OFF_W) + (size_t)l * WL_ELEMS;
            if (EN_GEMM && (s == 0 || s == 8 || s == 1 || s == 9 || s == 3 || s == 6)) {
                const int nsub = (s == 3) ? 2 : 1;
                for (int sub = 0; sub < nsub; ++sub) {
                    pg8::Gemm g; pg8::EpiAny E;
                    E.O = ACT; E.ldc = 2816; E.X = xp; E.gate = MOD; E.coef = 0.5f; E.mode = 0; E.perm = true;
                    E.stats = (const float2*)(wsp + OFF_STATS); E.lng = nullptr; E.lnb = nullptr;
                    if (s == 0 || s == 8) { g.A = Hb; g.Bt = wl + (s ? WO_WI2 : WO_WI1); g.M = MTOT; g.N = 5632; g.K = 1024; }
                    else if (s == 1 || s == 9) { g.A = ACT; g.Bt = wl + (s == 9 ? WO_WO2 : WO_WO1); g.M = MTOT; g.N = 1024; g.K = 2816;
                        E.mode = 1; E.perm = false; E.gate = MOD + (size_t)l * 32 * 9216 + (s == 9 ? 8 : 2) * 1024;
                        const int lnrow = (s == 9) ? l * 3 + 1 : l * 3 - 1;
                        if (lnrow >= 0) { E.lng = PIN[10] + (size_t)lnrow * 1024; E.lnb = PIN[11] + (size_t)lnrow * 1024; } }
                    else if (s == 6) { g.A = Hb; g.Bt = wl + WO_WOUT; g.M = MTOT; g.N = 1024; g.K = 1024;
                        E.mode = 1; E.perm = false; E.gate = MOD + (size_t)l * 32 * 9216 + 5 * 1024; E.coef = 1.0f;
                        E.lng = PIN[10] + (size_t)(l * 3) * 1024; E.lnb = PIN[11] + (size_t)(l * 3) * 1024; }
                    else if (sub == 0) { g.A = Hb; g.Bt = wl + WO_WINA; g.M = MTOT; g.N = 768; g.K = 1024; E.mode = 2; E.O = (bf16_t*)(wsp + OFF_ZA); E.ldc = 768; }
                    else { g.A = wl + WO_WINB; g.Bt = Hb; g.M = 1792; g.N = MTOT; g.K = 1024; E.mode = 2; E.O = (bf16_t*)(wsp + OFF_ZT); E.ldc = (size_t)MTOT; }
                    pg8::StaticOrder S; S.init(g.M, g.N, G, (s == 3 && sub == 1) ? G - 1 - wg : wg);
                    pg8::gemm_phase<pg8::EpiAny, pg8::StaticOrder, GEMM_ALIGN, GEMM_SP2>(lds, g, S, E);
                }
            } else if (EN_LN && (s == 2 || s == 7 || s == 10)) {
                const int li = s == 2 ? 0 : (s == 7 ? 1 : 2);
                const float* md = nullptr;
                if (s == 2) md = MOD + (size_t)l * 32 * 9216 + 3 * 1024;
                else if (s == 7) md = MOD + (size_t)l * 32 * 9216 + 6 * 1024;
                else if (l + 1 < NLAYER) md = MOD + (size_t)(l + 1) * 32 * 9216;
#ifdef PROBE_LN
                if (md) lnmod_phase(wsp, xp, PIN[10] + (size_t)(l * 3 + li) * 1024, PIN[11] + (size_t)(l * 3 + li) * 1024, md, md == nullptr);
#endif
                lnmod_phase(wsp, xp, PIN[10] + (size_t)(l * 3 + li) * 1024, PIN[11] + (size_t)(l * 3 + li) * 1024, md, md == nullptr);
            } else if (s == 4) {
#ifdef PROBE_ATT
                for (int ua = wg; ua < 1536; ua += G) attn_unit(p, l, ua, smem);
#endif
#ifdef PROBE_HY
                { for (int hu = wg; hu < 2048; hu += G) hyena_unit<13>(p, l, hu, smem, launder0() == 0); for (int hu = wg; hu < 2048; hu += G) hyena_unit<12>(p, l, hu, smem, launder0() == 0); }
#endif
                if (EN_ATT) for (int ua = wg; ua < 1536; ua += G) attn_unit(p, l, ua, smem);
                if (EN_HY) { for (int hu = wg; hu < 2048; hu += G) hyena_unit<13>(p, l, hu, smem); for (int hu = wg; hu < 2048; hu += G) hyena_unit<12>(p, l, hu, smem); }
            } else if (EN_RMS && s == 5) {
                for (int rc = wg; rc < 1536; rc += G) rms_unit(p, l, rc, smem);
            }
        }
#ifdef PROBE_SYNC
        if (ph + 1 < p.ph_hi) { grid.sync(); grid.sync(); grid.sync(); }
#endif
        if (ph + 1 < p.ph_hi) { if (ph == 0) grid.sync(); else xcd_barrier(xbar); }
    }
}

extern "C" void kernel_launch(void* const* d_in, const int* in_sizes, int n_in, void* d_out, int out_size, void* d_ws, size_t ws_size, hipStream_t stream) {
    static int grid = 0;
    if (grid == 0) {
        if (n_in != 28 || ws_size < WS_NEED) { fprintf(stderr, "kernel_launch: unexpected n_in %d or ws_size %zu (need %zu)\n", n_in, ws_size, (size_t)WS_NEED); grid = -1; return; }
        int dev = 0, cus = 0, per_cu = 0;
        (void)hipGetDevice(&dev);
        (void)hipDeviceGetAttribute(&cus, hipDeviceAttributeMultiprocessorCount, dev);
        if (hipFuncSetAttribute((const void*)hymba_fwd, hipFuncAttributeMaxDynamicSharedMemorySize, LDS_BYTES) != hipSuccess) { fprintf(stderr, "kernel_launch: hipFuncSetAttribute failed\n"); grid = -1; return; }
        if (hipOccupancyMaxActiveBlocksPerMultiprocessor(&per_cu, (const void*)hymba_fwd, 512, LDS_BYTES) != hipSuccess || per_cu < 1) { fprintf(stderr, "kernel_launch: occupancy query gave %d\n", per_cu); per_cu = 1; }
        (void)hipGetLastError();
        grid = cus * 1;
        if (grid <= 0) grid = 256;
    }
    if (grid < 0) return;
    Params p{};
    for (int i = 0; i < 28; ++i) p.in[i] = (const float*)d_in[i];
    p.X = (float*)d_out; p.ws = (unsigned char*)d_ws; p.ph_lo = 0; p.ph_hi = NPHASE;
    if (hipMemsetAsync((unsigned char*)d_ws + OFF_BAR, 0, BAR_BYTES, stream) != hipSuccess) { fprintf(stderr, "kernel_launch: memset of the barrier words failed\n"); return; }
    void* args[] = {&p};
    hipError_t e = hipLaunchCooperativeKernel((const void*)hymba_fwd, dim3(grid), dim3(512), args, LDS_BYTES, stream);
    if (e != hipSuccess) fprintf(stderr, "kernel_launch: cooperative launch failed: %s (grid %d)\n", hipGetErrorString(e), grid);
}
```

```cpp
#include <hip/hip_runtime.h>
#include <hip/hip_cooperative_groups.h>
#include <cstdio>
#include <cstdint>
namespace cg = cooperative_groups;
__device__ __forceinline__ int ltid() { int t = threadIdx.x; asm volatile("" : "+v"(t)); return t; }
template <class T> __device__ __forceinline__ T* lptr(T* q) { int z = 0; asm volatile("" : "+s"(z)); return q + z; }
namespace pg8 {
#define PG8_LAS __attribute__((address_space(3)))
typedef unsigned short bf16_t;
typedef short bf16x8 __attribute__((ext_vector_type(8)));
typedef float f32x4 __attribute__((ext_vector_type(4)));
typedef unsigned u32x4 __attribute__((ext_vector_type(4)));
constexpr int BM = 256, BK = 64, HALF = 128, HTB = HALF * BK * 2  , STAGE_BYTES = 8 * HTB, NXCD = 8, WGM = 8;

__host__ __device__ __forceinline__ int lds_byte(int r, int c) { const int st = (r >> 4) * 2 + (c >> 5), rr = r & 15, cc = c & 31, ob = rr * 64 + cc * 2; return st * 1024 + (ob ^ (((ob >> 9) & 1) << 5)); }
__host__ __device__ __forceinline__ void stage_rc(int b, int& R, int& C) { const int st = b / 1024, sb = b % 1024, swz = sb ^ (((sb >> 9) & 1) << 5); R = (st >> 1) * 16 + swz / 64; C = (st & 1) * 32 + (swz % 64) / 2; }
__host__ __device__ __forceinline__ int perm32(int rho) { const int n = rho >> 4, i = rho & 15; return 8 * (i >> 2) + 4 * n + (i & 3); }

struct Unit { int pm, pn; };
struct Gemm { const bf16_t* A; const bf16_t* Bt; int M, N, K; };
struct StaticOrder {
    int nM, nN, nwg, G, c;
    __host__ __device__ void init(int M, int N, int G_, int c_) { nM = M / BM; nN = N / BM; nwg = nM * nN; G = G_; c = c_; }
    __host__ __device__ bool next(int i, Unit& u) const {
        const long L = (long)i * G + c; if (L >= nwg) return false;
        int wgid = (int)L; { const int q = nwg / NXCD, r = nwg % NXCD, xcd = wgid % NXCD, off = wgid / NXCD; wgid = (xcd < r ? xcd * (q + 1) : r * (q + 1) + (xcd - r) * q) + off; }
        const int nig = WGM * nN, gid = wgid / nig, fm = gid * WGM, gsz = (nM - fm) < WGM ? (nM - fm) : WGM;
        u.pm = fm + ((wgid % nig) % gsz); u.pn = (wgid % nig) / gsz; return true;
    }
    __device__ __forceinline__ void a_ready(const Unit&) const {}
    __device__ __forceinline__ void done(const Unit&) const {}
};
__device__ __forceinline__ unsigned cvt_pk_bf16(float lo, float hi) { unsigned r; asm("v_cvt_pk_bf16_f32 %0, %1, %2" : "=v"(r) : "v"(lo), "v"(hi)); return r; }
struct EpiSwiGLU {
    static constexpr bool PERM = true, AFTER_DRAIN = false;
    bf16_t* O;
    __device__ __forceinline__ void operator()(const f32x4 (&acc)[2][2][4][2], const Unit& u, int wr, int wc, int fr, int fq) const {
        const int row0 = u.pm * BM + wr * 64 + fr, col0 = u.pn * 128 + wc * 32 + 8 * fq;
#pragma unroll
        for (int ai = 0; ai < 2; ++ai)
#pragma unroll
            for (int m = 0; m < 4; ++m) {
                bf16_t* p = O + (size_t)(row0 + ai * HALF + m * 16) * 2816 + col0;
                float v[8];
#pragma unroll
                for (int n = 0; n < 2; ++n)
#pragma unroll
                    for (int j = 0; j < 4; ++j) { const float g = acc[ai][0][m][n][j], uu = acc[ai][1][m][n][j]; v[n * 4 + j] = g * uu * __builtin_amdgcn_rcpf(1.0f + __expf(-g)); }
                u32x4 pk; pk[0] = cvt_pk_bf16(v[0], v[1]); pk[1] = cvt_pk_bf16(v[2], v[3]); pk[2] = cvt_pk_bf16(v[4], v[5]); pk[3] = cvt_pk_bf16(v[6], v[7]);
                *(u32x4*)p = pk;
            }
    }
};
struct EpiResid {
    static constexpr bool PERM = false, AFTER_DRAIN = false;
    float* X; const float* gate; float coef; const float2* stats; const float* lng; const float* lnb;
    __device__ __forceinline__ void operator()(const f32x4 (&acc)[2][2][4][2], const Unit& u, int wr, int wc, int fr, int fq) const {
        const int bidx = u.pm < 256 ? (u.pm >> 4) : 16 + ((u.pm - 256) >> 3);
        const int row0 = u.pm * BM + wr * 64 + fr, col0 = u.pn * BM + wc * 32 + 4 * fq;
        const float* gp = gate + (size_t)bidx * 9216 + col0;
#pragma unroll
        for (int bj = 0; bj < 2; ++bj)
#pragma unroll
            for (int n = 0; n < 2; ++n) {
                const int co = bj * HALF + n * 16;
                const f32x4 gt = (*(const f32x4*)(gp + co) + 1.0f) * coef;
                f32x4 gg = {1.f, 1.f, 1.f, 1.f}, be = {0.f, 0.f, 0.f, 0.f};
                if (lng) { gg = *(const f32x4*)(lng + col0 + co); be = *(const f32x4*)(lnb + col0 + co); }
#pragma unroll
                for (int ai = 0; ai < 2; ++ai) {
                    f32x4 xv[4]; float2 st[4];
                    int zv = 0; asm volatile("" : "+v"(zv));
                    float* xb = X + (size_t)(row0 + ai * HALF) * 1024 + col0 + co + zv;
                    const float2* sb = stats + row0 + ai * HALF + zv;
#pragma unroll
                    for (int m = 0; m < 4; ++m) { xv[m] = *(const f32x4*)(xb + m * 16384); st[m] = sb[m * 16]; }
#pragma unroll
                    for (int m = 0; m < 4; ++m) {
                        const float mu = lng ? st[m].x : 0.f, rs = lng ? st[m].y : 1.f;
                        const f32x4 xl = (xv[m] - mu) * rs * gg + be;
                        *(f32x4*)(xb + m * 16384) = xl * 1.681792830507429f + gt * acc[ai][bj][m][n];
                    }
                }
            }
    }
};
struct EpiStore {
    static constexpr bool PERM = true, AFTER_DRAIN = false;
    bf16_t* O; size_t ldc;
    __device__ __forceinline__ void operator()(const f32x4 (&acc)[2][2][4][2], const Unit& u, int wr, int wc, int fr, int fq) const {
        const int row0 = u.pm * BM + wr * 64 + fr, col0 = u.pn * BM + wc * 32 + 8 * fq;
#pragma unroll
        for (int ai = 0; ai < 2; ++ai)
#pragma unroll
            for (int m = 0; m < 4; ++m) { bf16_t* p = O + (size_t)(row0 + ai * HALF + m * 16) * ldc + col0;
#pragma unroll
                for (int bj = 0; bj < 2; ++bj) { const f32x4 v0 = acc[ai][bj][m][0], v1 = acc[ai][bj][m][1];
                    u32x4 pk; pk[0] = cvt_pk_bf16(v0[0], v0[1]); pk[1] = cvt_pk_bf16(v0[2], v0[3]); pk[2] = cvt_pk_bf16(v1[0], v1[1]); pk[3] = cvt_pk_bf16(v1[2], v1[3]);
                    *(u32x4*)(p + bj * HALF) = pk; } }
    }
};

struct EpiAny {
    static constexpr bool AFTER_DRAIN = false;
    int mode; bool perm; bf16_t* O; size_t ldc; float* X; const float* gate; float coef; const float2* stats; const float* lng; const float* lnb;
    __device__ __forceinline__ void operator()(const f32x4 (&acc)[2][2][4][2], const Unit& u, int wr, int wc, int fr, int fq) const {
        if (mode == 0) { EpiSwiGLU e{O}; e(acc, u, wr, wc, fr, fq); }
        else if (mode == 1) { EpiResid e{X, gate, coef, stats, lng, lnb}; e(acc, u, wr, wc, fr, fq); }
        else { EpiStore e{O, ldc}; e(acc, u, wr, wc, fr, fq); }
    }
};
template <class Epi, class Sched, bool ALIGN_EPI = false, bool SP2 = false>
__device__ __forceinline__ void gemm_phase(PG8_LAS unsigned char* lds, const Gemm g, const Sched& S, const Epi& E) {
    const int tid = ltid(), wid = __builtin_amdgcn_readfirstlane(tid >> 6), lane = tid & 63, wr = wid >> 2, wc = wid & 3, fr = lane & 15, fq = lane >> 4;
    const int K = g.K, nt = K / BK;
    unsigned voffA[2], voffB[2];
#pragma unroll
    for (int i = 0; i < 2; ++i) { int R, C; stage_rc(tid * 16 + i * 8192, R, C); const int Rb = E.perm ? ((R & ~31) + perm32(R & 31)) : R;
        voffA[i] = (unsigned)(R * K + C) * 2u; voffB[i] = (unsigned)(Rb * K + C) * 2u; }
    const size_t kstep = (size_t)(BK * 2);
    const size_t hstep = (size_t)HALF * K * 2;
    const size_t tstep = 2 * hstep;
    const unsigned ldsw = (unsigned)wid * 1024u;
    const int aoff = lds_byte(wr * 64 + fr, fq * 8), boff = lds_byte(wc * 32 + fr, fq * 8);
#define PG8_SA(b, h) (((b) * 2 + (h)) * HTB)
#define PG8_SB(b, h) ((4 + (b) * 2 + (h)) * HTB)
#define PG8_STAGE(bufoff, gbase, voff) do { _Pragma("unroll") for (int _i = 0; _i < 2; ++_i) \
        __builtin_amdgcn_global_load_lds((const unsigned*)((const char*)(gbase) + (voff)[_i]), (PG8_LAS unsigned*)(lds + (bufoff) + ldsw + _i * 8192), 16, 0, 0); } while (0)
#define PG8_LDA(dst, b, h) do { _Pragma("unroll") for (int m = 0; m < 4; ++m) _Pragma("unroll") for (int k = 0; k < 2; ++k) dst[m][k] = *(const PG8_LAS bf16x8*)(lds + PG8_SA(b, h) + aoff + m * 2048 + k * 1024); } while (0)
#define PG8_LDB(dst, b, h) do { _Pragma("unroll") for (int n = 0; n < 2; ++n) _Pragma("unroll") for (int k = 0; k < 2; ++k) dst[n][k] = *(const PG8_LAS bf16x8*)(lds + PG8_SB(b, h) + boff + n * 2048 + k * 1024); } while (0)
#define PG8_MMA(ai, bj, At, Bt) do { __builtin_amdgcn_s_setprio(1); _Pragma("unroll") for (int m = 0; m < 4; ++m) _Pragma("unroll") for (int n = 0; n < 2; ++n) _Pragma("unroll") for (int k = 0; k < 2; ++k) \
        acc[ai][bj][m][n] = __builtin_amdgcn_mfma_f32_16x16x32_bf16(Bt[n][k], At[m][k], acc[ai][bj][m][n], 0, 0, 0); __builtin_amdgcn_s_setprio(0); } while (0)
#define PG8_WAIT_V(n) asm volatile("s_waitcnt vmcnt(" #n ")" ::: "memory")
#define PG8_WAIT_L(n) asm volatile("s_waitcnt lgkmcnt(" #n ")" ::: "memory")
#define PG8_BAR __builtin_amdgcn_s_barrier()
#define PG8_SCHED __builtin_amdgcn_sched_barrier(0)
    Unit cur, nxt; int ui = 0;
    if (!S.next(0, cur)) return;
    f32x4 acc[2][2][4][2];
#pragma unroll
    for (int a = 0; a < 2; ++a)
#pragma unroll
        for (int b = 0; b < 2; ++b)
#pragma unroll
            for (int m = 0; m < 4; ++m)
#pragma unroll
                for (int n = 0; n < 2; ++n) acc[a][b][m][n] = (f32x4){0.f, 0.f, 0.f, 0.f};
    bf16x8 At[4][2], B0[2][2], B1[2][2];
    const char* cA = (const char*)g.A + (size_t)cur.pm * tstep; const char* cB = (const char*)g.Bt + (size_t)cur.pn * tstep;
    S.a_ready(cur);
    if constexpr (SP2) {
        PG8_STAGE(PG8_SB(0, 0), cB, voffB); PG8_STAGE(PG8_SB(0, 1), cB + hstep, voffB); PG8_STAGE(PG8_SA(0, 0), cA, voffA); PG8_STAGE(PG8_SA(0, 1), cA + hstep, voffA);
        if (wr == 1) PG8_BAR;
        PG8_WAIT_V(2); PG8_BAR;
        PG8_STAGE(PG8_SB(1, 0), cB + kstep, voffB); PG8_STAGE(PG8_SA(1, 0), cA + kstep, voffA); PG8_STAGE(PG8_SB(1, 1), cB + hstep + kstep, voffB);
        PG8_WAIT_V(6); PG8_BAR;
    } else {
        PG8_STAGE(PG8_SB(0, 0), cB, voffB); PG8_STAGE(PG8_SA(0, 0), cA, voffA); PG8_STAGE(PG8_SB(0, 1), cB + hstep, voffB); PG8_STAGE(PG8_SA(0, 1), cA + hstep, voffA);
        if (wr == 1) PG8_BAR;
        PG8_WAIT_V(4); PG8_BAR;
        PG8_STAGE(PG8_SB(1, 0), cB + kstep, voffB); PG8_STAGE(PG8_SA(1, 0), cA + kstep, voffA); PG8_STAGE(PG8_SB(1, 1), cB + hstep + kstep, voffB);
        PG8_WAIT_V(6); PG8_BAR;
    }
    for (;;) {
        const bool has_next = S.next(ui + 1, nxt);
        const char* nA = has_next ? (const char*)g.A + (size_t)nxt.pm * tstep : cA; const char* nB = has_next ? (const char*)g.Bt + (size_t)nxt.pn * tstep : cB;
        for (int t = 0; t < nt; t += 2) {
            const bool last = (t == nt - 2);
            const char* a1 = cA + (size_t)(t + 1) * kstep;
            const char* a2 = last ? nA : cA + (size_t)(t + 2) * kstep; const char* b2 = last ? nB : cB + (size_t)(t + 2) * kstep;
            const char* a3 = a2 + kstep; const char* b3 = b2 + kstep;
            if (last && has_next) S.a_ready(nxt);
            if constexpr (SP2) {
            PG8_LDB(B0, 0, 0); PG8_LDB(B1, 0, 1); PG8_SCHED; PG8_LDA(At, 0, 0); PG8_STAGE(PG8_SA(1, 1), a1 + hstep, voffA);
            PG8_WAIT_V(8); PG8_WAIT_L(0); PG8_BAR; PG8_MMA(0, 0, At, B0); PG8_MMA(0, 1, At, B1); PG8_BAR; PG8_SCHED;
            PG8_LDA(At, 0, 1); PG8_STAGE(PG8_SB(0, 0), b2, voffB); PG8_STAGE(PG8_SB(0, 1), b2 + hstep, voffB); PG8_STAGE(PG8_SA(0, 0), a2, voffA);
            PG8_WAIT_V(8); PG8_WAIT_L(0); PG8_BAR; PG8_MMA(1, 0, At, B0); PG8_MMA(1, 1, At, B1); PG8_BAR; PG8_SCHED;
            PG8_LDB(B0, 1, 0); PG8_LDB(B1, 1, 1); PG8_SCHED; PG8_LDA(At, 1, 0); PG8_STAGE(PG8_SA(0, 1), a2 + hstep, voffA);
            PG8_WAIT_V(8); PG8_WAIT_L(0); PG8_BAR; PG8_MMA(0, 0, At, B0); PG8_MMA(0, 1, At, B1); PG8_BAR; PG8_SCHED;
            PG8_LDA(At, 1, 1); PG8_STAGE(PG8_SB(1, 0), b3, voffB); PG8_STAGE(PG8_SB(1, 1), b3 + hstep, voffB); PG8_STAGE(PG8_SA(1, 0), a3, voffA);
            PG8_WAIT_V(8); PG8_WAIT_L(0); PG8_BAR; PG8_MMA(1, 0, At, B0); PG8_MMA(1, 1, At, B1); PG8_BAR; PG8_SCHED;
            } else {
            PG8_LDB(B0, 0, 0); PG8_SCHED; PG8_LDA(At, 0, 0); PG8_STAGE(PG8_SA(1, 1), a1 + hstep, voffA);
            PG8_WAIT_L(8); PG8_BAR; PG8_WAIT_L(0); PG8_MMA(0, 0, At, B0); PG8_BAR; PG8_SCHED;
            PG8_LDB(B1, 0, 1); PG8_STAGE(PG8_SB(0, 0), b2, voffB);
            PG8_BAR; PG8_WAIT_L(0); PG8_MMA(0, 1, At, B1); PG8_BAR;
            PG8_LDA(At, 0, 1); PG8_STAGE(PG8_SA(0, 0), a2, voffA);
            PG8_BAR; PG8_WAIT_L(0); PG8_MMA(1, 0, At, B0); PG8_BAR; PG8_SCHED;
            PG8_STAGE(PG8_SB(0, 1), b2 + hstep, voffB);
            PG8_WAIT_V(6); PG8_BAR; PG8_MMA(1, 1, At, B1); PG8_BAR;
            PG8_LDB(B0, 1, 0); PG8_SCHED; PG8_LDA(At, 1, 0); PG8_STAGE(PG8_SA(0, 1), a2 + hstep, voffA);
            PG8_WAIT_L(8); PG8_BAR; PG8_WAIT_L(0); PG8_MMA(0, 0, At, B0); PG8_BAR; PG8_SCHED;
            PG8_LDB(B1, 1, 1); PG8_STAGE(PG8_SB(1, 0), b3, voffB);
            PG8_BAR; PG8_WAIT_L(0); PG8_MMA(0, 1, At, B1); PG8_BAR;
            PG8_LDA(At, 1, 1); PG8_STAGE(PG8_SA(1, 0), a3, voffA);
            PG8_BAR; PG8_WAIT_L(0); PG8_MMA(1, 0, At, B0); PG8_BAR; PG8_SCHED;
            PG8_STAGE(PG8_SB(1, 1), b3 + hstep, voffB);
            PG8_WAIT_V(6); PG8_BAR; PG8_MMA(1, 1, At, B1); PG8_BAR;
            }
        }
        if constexpr (ALIGN_EPI) { if (wr == 0) PG8_BAR; }
        if constexpr (!Epi::AFTER_DRAIN) { E(acc, cur, wr, wc, fr, fq); S.done(cur); }
        if (!has_next) break;
#pragma unroll
        for (int a = 0; a < 2; ++a)
#pragma unroll
            for (int b = 0; b < 2; ++b)
#pragma unroll
                for (int m = 0; m < 4; ++m)
#pragma unroll
                    for (int n = 0; n < 2; ++n) acc[a][b][m][n] = (f32x4){0.f, 0.f, 0.f, 0.f};
        cur = nxt; cA = nA; cB = nB; ++ui;
        if constexpr (ALIGN_EPI) { if (wr == 1) PG8_BAR; }
    }
    PG8_WAIT_V(0);
    if constexpr (!ALIGN_EPI) { if (wr == 0) PG8_BAR; }
    PG8_BAR;
    if constexpr (Epi::AFTER_DRAIN) { E.fused(acc, cur, wr, wc, fr, fq, lds, wid, lane); S.done(cur); }
#undef PG8_SA
#undef PG8_SB
#undef PG8_STAGE
#undef PG8_LDA
#undef PG8_LDB
#undef PG8_MMA
#undef PG8_WAIT_V
#undef PG8_WAIT_L
#undef PG8_BAR
#undef PG8_SCHED
}
}

typedef unsigned short bf16_t;
typedef short bf16x8 __attribute__((ext_vector_type(8)));
typedef float f32x4 __attribute__((ext_vector_type(4)));
typedef float f32x16 __attribute__((ext_vector_type(16)));
typedef unsigned u32x4 __attribute__((ext_vector_type(4)));
typedef unsigned u32x2 __attribute__((ext_vector_type(2)));

constexpr int MTOT = 98304, NLAYER = 4;
constexpr size_t WL_ELEMS = 20971520;
constexpr size_t WO_WI1 = 0, WO_WO1 = 5767168, WO_WI2 = 8650752, WO_WO2 = 14417920, WO_WINA = 17301504, WO_WINB = 18087936, WO_WOUT = 19922944;
constexpr size_t OFF_W = 0;
constexpr size_t OFF_MOD = 167772160;
constexpr size_t OFF_ROPE = OFF_MOD + 4718592;
constexpr size_t OFF_H3 = OFF_ROPE + 262144;
constexpr size_t OFF_KF = OFF_H3 + 6291456;
constexpr int KS4 = 4104, KS2 = 2056;
constexpr size_t KF_LAYER = (size_t)512 * (KS4 + KS2);
constexpr size_t OFF_H = OFF_KF + 4 * KF_LAYER * 8;
constexpr size_t OFF_ACT = OFF_H + (size_t)MTOT * 1024 * 2;
constexpr size_t OFF_ZA = OFF_ACT;
constexpr size_t OFF_ZT = OFF_ACT + (size_t)MTOT * 768 * 2;
constexpr size_t OFF_STATS = OFF_ACT + (size_t)MTOT * 2816 * 2;
constexpr size_t OFF_BAR = OFF_STATS + (size_t)MTOT * 8;
constexpr size_t BAR_BYTES = 16384;
constexpr size_t WS_NEED = OFF_BAR + BAR_BYTES;
static_assert(OFF_ZT + (size_t)1792 * MTOT * 2 <= OFF_STATS, "mixer overlay fits");
constexpr int LDS_BYTES = 137216;
constexpr int NPHASE = 2 + 11 * NLAYER;
#ifndef GEMM_ALIGN
#define GEMM_ALIGN true
#endif
#ifndef GEMM_SP2
#define GEMM_SP2 true
#endif
#ifndef EN_GEMM
#define EN_GEMM 1
#endif
#ifndef EN_LN
#define EN_LN 1
#endif
#ifndef EN_ATT
#define EN_ATT 1
#endif
#ifndef EN_HY
#define EN_HY 1
#endif
#ifndef EN_RMS
#define EN_RMS 1
#endif
#ifndef EN_P0
#define EN_P0 1
#endif
#ifndef EN_P1
#define EN_P1 1
#endif

struct Params { const float* in[28]; float* X; unsigned char* ws; int ph_lo, ph_hi; };
#define PIN (p.in + zl)
__device__ __forceinline__ int launder0() { int z = 0; asm volatile("" : "+s"(z)); return z; }

__device__ __forceinline__ float bf_lo(unsigned u) { return __uint_as_float(u << 16); }
__device__ __forceinline__ float bf_hi(unsigned u) { return __uint_as_float(u & 0xffff0000u); }
__device__ __forceinline__ float bf2f(bf16_t b) { return __uint_as_float(((unsigned)b) << 16); }
__device__ __forceinline__ unsigned pk2(float lo, float hi) { return pg8::cvt_pk_bf16(lo, hi); }
__device__ __forceinline__ float sin_rev(float r) { return __builtin_amdgcn_sinf(r); }
__device__ __forceinline__ float cos_rev(float r) { return __builtin_amdgcn_cosf(r); }
__device__ __forceinline__ float sin_rad(float x) { float r = x * 0.15915494309189535f; r -= rintf(r); return __builtin_amdgcn_sinf(r); }
__device__ __forceinline__ float cos_rad(float x) { float r = x * 0.15915494309189535f; r -= rintf(r); return __builtin_amdgcn_cosf(r); }
__device__ __forceinline__ float wave_sum(float v) {
#pragma unroll
    for (int o = 1; o < 64; o <<= 1) v += __shfl_xor(v, o);
    return v;
}
__device__ __forceinline__ int row_bidx(int row) { return row < 65536 ? (row >> 12) : 16 + ((row - 65536) >> 11); }

__device__ __forceinline__ void cvt_tile(const float* __restrict__ src, int ldN, int k0, int c0, bf16_t* __restrict__ dst, int ldK, int n0, bool zero, float* tile) {
    const int tid = ltid();
    {
        const int r = tid >> 4, c4 = (tid & 15) * 4;
#pragma unroll
        for (int ps = 0; ps < 2; ++ps) {
            const int k = r + 32 * ps;
            f32x4 v = {0.f, 0.f, 0.f, 0.f};
            if (!zero) v = *(const f32x4*)(src + (size_t)(k0 + k) * ldN + c0 + c4);
            tile[k * 65 + c4 + 0] = v[0]; tile[k * 65 + c4 + 1] = v[1]; tile[k * 65 + c4 + 2] = v[2]; tile[k * 65 + c4 + 3] = v[3];
        }
    }
    __syncthreads();
    {
        const int n = tid >> 3, kq = tid & 7;
        float f[8];
#pragma unroll
        for (int j = 0; j < 8; ++j) f[j] = tile[(kq * 8 + j) * 65 + n];
        u32x4 pk; pk[0] = pk2(f[0], f[1]); pk[1] = pk2(f[2], f[3]); pk[2] = pk2(f[4], f[5]); pk[3] = pk2(f[6], f[7]);
        *(u32x4*)(dst + (size_t)(n0 + n) * ldK + k0 + kq * 8) = pk;
    }
    __syncthreads();
}

__device__ __forceinline__ void phase0a(const Params& p, unsigned char* smem) {
    const int zl = launder0(); unsigned char* const wsp = lptr(p.ws); float* const xp = lptr(p.X); (void)xp;
    const int tid = ltid();
    float* tile = (float*)smem;
    for (int t = blockIdx.x; t < 20480; t += gridDim.x) {
        const int l = t / 5120, r = t % 5120;
        bf16_t* wl = (bf16_t*)(wsp + OFF_W) + (size_t)l * WL_ELEMS;
        const float* src; int ldN, k0, c0, ldK, n0; bf16_t* dst; bool zero = false;
        if (r < 2816) {
            const int which = r / 1408, rr = r % 1408, nt = rr / 16, kt = rr % 16;
            src = PIN[which ? 8 : 6] + (size_t)l * 1024 * 5632; ldN = 5632; k0 = kt * 64; n0 = nt * 64;
            const int tt = n0 >> 8, within = n0 & 255;
            c0 = within < 128 ? 128 * tt + within : 2816 + 128 * tt + (within - 128);
            dst = wl + (which ? WO_WI2 : WO_WI1); ldK = 1024;
        } else if (r < 4224) {
            const int q = r - 2816, which = q / 704, rr = q % 704, nt = rr / 44, kt = rr % 44;
            src = PIN[which ? 9 : 7] + (size_t)l * 2816 * 1024; ldN = 1024; k0 = kt * 64; n0 = nt * 64; c0 = n0;
            dst = wl + (which ? WO_WO2 : WO_WO1); ldK = 2816;
        } else if (r < 4416) {
            const int q = r - 4224, nt = q / 16, kt = q % 16;
            src = PIN[12] + (size_t)l * 1024 * 2304; ldN = 2304; k0 = kt * 64; n0 = nt * 64; c0 = n0;
            dst = wl + WO_WINA; ldK = 1024;
        } else if (r < 4864) {
            const int q = r - 4416, nt = q / 16, kt = q % 16;
            src = PIN[12] + (size_t)l * 1024 * 2304; ldN = 2304; k0 = kt * 64; n0 = nt * 64;
            if (n0 < 1536) c0 = 768 + n0; else if (n0 < 1664) c0 = 640 + (n0 - 1536); else { c0 = 0; zero = true; }
            dst = wl + WO_WINB; ldK = 1024;
        } else {
            const int q = r - 4864, nt = q / 16, kt = q % 16;
            src = PIN[13] + (size_t)l * 1024 * 1024; ldN = 1024; k0 = kt * 64; n0 = nt * 64; c0 = n0;
            dst = wl + WO_WOUT; ldK = 1024;
        }
        cvt_tile(src, ldN, k0, c0, dst, ldK, n0, zero, tile);
    }
    {
        float* sc = (float*)smem;
        float* MOD = (float*)(wsp + OFF_MOD);
        for (int u = blockIdx.x; u < 288; u += gridDim.x) {
            const int l = u / 72, cch = u % 72;
            for (int idx = tid; idx < 32768; idx += 512) {
                const int b = idx >> 10, k = idx & 1023;
                const float c = b < 16 ? PIN[2][b * 1024 + k] : PIN[3][(b - 16) * 1024 + k];
                sc[k * 32 + b] = c / (1.0f + __expf(-c));
            }
            __syncthreads();
            const int cl = tid & 127, ks = tid >> 7, col = cch * 128 + cl;
            float acc[32];
#pragma unroll
            for (int b = 0; b < 32; ++b) acc[b] = 0.f;
            const float* wp = PIN[4] + ((size_t)l * 1024 + ks * 256) * 9216 + col;
            for (int k = 0; k < 256; ++k) {
                const float w = wp[(size_t)k * 9216];
                const f32x4* sp = (const f32x4*)(sc + (ks * 256 + k) * 32);
#pragma unroll
                for (int b4 = 0; b4 < 8; ++b4) { const f32x4 s = sp[b4]; acc[b4 * 4 + 0] += s[0] * w; acc[b4 * 4 + 1] += s[1] * w; acc[b4 * 4 + 2] += s[2] * w; acc[b4 * 4 + 3] += s[3] * w; }
            }
            __syncthreads();
            float* part = (float*)smem;
#pragma unroll
            for (int b = 0; b < 32; ++b) part[(ks * 32 + b) * 128 + cl] = acc[b];
            __syncthreads();
            for (int idx = tid; idx < 4096; idx += 512) {
                const int b = idx >> 7, c2 = idx & 127, cc = cch * 128 + c2;
                const float s = part[(0 * 32 + b) * 128 + c2] + part[(1 * 32 + b) * 128 + c2] + part[(2 * 32 + b) * 128 + c2] + part[(3 * 32 + b) * 128 + c2];
                MOD[((size_t)l * 32 + b) * 9216 + cc] = s + PIN[5][l * 9216 + cc];
            }
            __syncthreads();
        }
    }
    {
        float* zb = (float*)smem; float* ha = zb + 8 * 40; float* hb = ha + 8 * 64;
        float* H3 = (float*)(wsp + OFF_H3);
        for (int u = blockIdx.x; u < 384; u += gridDim.x) {
            const int l = u / 96, v = u % 96;
            const int Lsel = v >= 64, chunk = Lsel ? v - 64 : v, L = Lsel ? 2048 : 4096;
            const int lr = tid >> 6, j = tid & 63;
            const float fr = PIN[25][l * 64 + j];
            for (int it = 0; it < 8; ++it) {
                const int pos = chunk * 64 + it * 8 + lr;
                if (j < 33) {
                    const float tt = (float)pos / (float)(L - 1), w = (6.2831855f * (float)pos) / (float)L;
                    float val;
                    if (j == 0) val = tt;
                    else if (j <= 16) { const float fb = 1e-4f + (float)(j - 1) * 0.99999333f; val = cos_rad(fb * w); }
                    else { const float fb = 1e-4f + (float)(j - 17) * 0.99999333f; val = -sin_rad(fb * w); }
                    zb[lr * 40 + j] = val;
                }
                __syncthreads();
                float a = PIN[19][l * 64 + j];
                for (int i = 0; i < 33; ++i) a += zb[lr * 40 + i] * PIN[18][((size_t)l * 33 + i) * 64 + j];
                ha[lr * 64 + j] = sin_rad(fr * a);
                __syncthreads();
                a = PIN[21][l * 64 + j];
                for (int i = 0; i < 64; ++i) a += ha[lr * 64 + i] * PIN[20][((size_t)l * 64 + i) * 64 + j];
                hb[lr * 64 + j] = sin_rad(fr * a);
                __syncthreads();
                a = PIN[23][l * 64 + j];
                for (int i = 0; i < 64; ++i) a += hb[lr * 64 + i] * PIN[22][((size_t)l * 64 + i) * 64 + j];
                H3[((size_t)l * 6144 + (Lsel ? 4096 : 0) + pos) * 64 + j] = sin_rad(fr * a);
                __syncthreads();
            }
        }
    }
    {
        const double INV[8] = {1.0, 0.19392274474868576, 0.03760603093086393, 0.007292664737217109, 0.001414213562373095, 0.0002742481756762073, 5.318295896944988e-05, 1.031338537721246e-05};
        float2* rope = (float2*)(wsp + OFF_ROPE);
        for (int idx = blockIdx.x * 512 + tid; idx < 32768; idx += gridDim.x * 512) {
            const int pos = idx >> 3, i = idx & 7;
            double inv = INV[0];
#pragma unroll
            for (int q = 1; q < 8; ++q) inv = (i == q) ? INV[q] : inv;
            double r = (double)pos * inv * 0.15915494309189535; r -= rint(r);
            const float rf = (float)r;
            rope[idx] = make_float2(cos_rev(rf), sin_rev(rf));
        }
    }
}

__device__ __forceinline__ int PIX(int i) { return i + (i >> 5); }
constexpr int FFT_LDS_BYTES = (8192 + 256) * 8;
__device__ __forceinline__ float2 cmul(float2 a, float2 b) { return make_float2(a.x * b.x - a.y * b.y, a.x * b.y + a.y * b.x); }
__device__ __forceinline__ float2 cmulc(float2 a, float2 b) { return make_float2(a.x * b.x + a.y * b.y, a.y * b.x - a.x * b.y); }
#define ROOT16X(k) ((k) == 0 ? 1.0f : (k) == 1 ? 0.92387953251f : (k) == 2 ? 0.70710678119f : (k) == 3 ? 0.38268343237f : (k) == 4 ? 0.0f : (k) == 5 ? -0.38268343237f : (k) == 6 ? -0.70710678119f : -0.92387953251f)
#define ROOT16Y(k) ((k) == 0 ? 0.0f : (k) == 1 ? -0.38268343237f : (k) == 2 ? -0.70710678119f : (k) == 3 ? -0.92387953251f : (k) == 4 ? -1.0f : (k) == 5 ? -0.92387953251f : (k) == 6 ? -0.70710678119f : -0.38268343237f)
constexpr int FFT_BUF_STRIDE = 8192 + 256;
template <int LOGN, int S, int R, bool INV, int NB>
__device__ __forceinline__ void fft_pass(float2* buf, int tid) {
    constexpr int RR = 1 << R, N = 1 << LOGN, lgD = LOGN - S - R, D = 1 << lgD, ngroups = N >> R;
    static_assert(D >= 32 || D == 16 || D == 2 || D == 1, "padded-index shortcut");
    for (int gidx = tid; gidx < ngroups; gidx += 512) {
        const int lo = gidx & (D - 1), hi = gidx >> lgD, base = (hi << (LOGN - S)) + lo, pb = PIX(base);
        const float fr = (float)lo * (1.0f / (float)(D << R));
        float2 wq[R];
        wq[0] = make_float2(cos_rev(fr), -sin_rev(fr));
#pragma unroll
        for (int q = 1; q < R; ++q) wq[q] = cmul(wq[q - 1], wq[q - 1]);
        float2 tw[RR];
#pragma unroll
        for (int q = 0; q < R; ++q) {
            const int h = 1 << (R - 1 - q);
#pragma unroll
            for (int k = 0; k < h; ++k) { const int ri = k << (4 - R + q); tw[RR - 2 * h + k] = cmul(wq[q], make_float2(ROOT16X(ri), ROOT16Y(ri))); }
        }
#pragma unroll
        for (int nb = 0; nb < NB; ++nb) {
            float2* bb = buf + nb * FFT_BUF_STRIDE;
            float2 v[RR];
#pragma unroll
            for (int m = 0; m < RR; ++m) v[m] = bb[pb + m * D + ((m * D) >> 5)];
#pragma unroll
            for (int qq = 0; qq < R; ++qq) {
                const int q = INV ? (R - 1 - qq) : qq;
                const int h = 1 << (R - 1 - q);
#pragma unroll
                for (int k = 0; k < h; ++k) {
                    const float2 t_w = tw[RR - 2 * h + k];
#pragma unroll
                    for (int blk = 0; blk < RR; blk += 2 * h) {
                        const int m0 = blk + k, m1 = m0 + h;
                        const float2 a = v[m0], b = v[m1];
                        if (!INV) { v[m0] = make_float2(a.x + b.x, a.y + b.y); v[m1] = cmul(make_float2(a.x - b.x, a.y - b.y), t_w); }
                        else { const float2 t = cmulc(b, t_w); v[m0] = make_float2(a.x + t.x, a.y + t.y); v[m1] = make_float2(a.x - t.x, a.y - t.y); }
                    }
                }
            }
#pragma unroll
            for (int m = 0; m < RR; ++m) bb[pb + m * D + ((m * D) >> 5)] = v[m];
        }
    }
    __syncthreads();
}
template <int LOGN, int NB> __device__ __forceinline__ void fft_fwd(float2* buf, int tid) {
    fft_pass<LOGN, 0, 4, false, NB>(buf, tid); fft_pass<LOGN, 4, 4, false, NB>(buf, tid); fft_pass<LOGN, 8, 4, false, NB>(buf, tid);
    if constexpr (LOGN == 13) fft_pass<LOGN, 12, 1, false, NB>(buf, tid);
}
template <int LOGN, int NB> __device__ __forceinline__ void fft_inv(float2* buf, int tid) {
    if constexpr (LOGN == 13) fft_pass<LOGN, 12, 1, true, NB>(buf, tid);
    fft_pass<LOGN, 8, 4, true, NB>(buf, tid); fft_pass<LOGN, 4, 4, true, NB>(buf, tid); fft_pass<LOGN, 0, 4, true, NB>(buf, tid);
}

template <int LOGN>
__device__ __forceinline__ void filt_unit(const Params& p, int l, int cp, unsigned char* smem, int zl, unsigned char* wsp) {
    const int tid = ltid();
    float2* buf = (float2*)smem; float* w4s = (float*)(smem + 69632);
    const float* H3 = (const float*)(wsp + OFF_H3);
    float2* KF = (float2*)(wsp + OFF_KF);
    {
        constexpr int Lsel = (LOGN == 12), L = 1 << (LOGN - 1), logN = LOGN, N = 2 * L;
        if (tid < 256) { const int i = tid >> 2, q = tid & 3; w4s[tid] = PIN[24][((size_t)l * 64 + i) * 1024 + (q >> 1) * 512 + 2 * cp + (q & 1)]; }
        const float d00 = fabsf(PIN[26][(l * 2 + 0) * 512 + 2 * cp]), d01 = fabsf(PIN[26][(l * 2 + 0) * 512 + 2 * cp + 1]);
        const float d10 = fabsf(PIN[26][(l * 2 + 1) * 512 + 2 * cp]), d11 = fabsf(PIN[26][(l * 2 + 1) * 512 + 2 * cp + 1]);
        __syncthreads();
#pragma nounroll
        for (int pos = tid; pos < L; pos += 512) {
            const f32x4* hrow = (const f32x4*)(H3 + ((size_t)l * 6144 + (Lsel ? 4096 : 0) + pos) * 64);
            float a0 = 0.f, a1 = 0.f, a2 = 0.f, a3 = 0.f;
#pragma unroll
            for (int i4 = 0; i4 < 16; ++i4) {
                const f32x4 h = hrow[i4];
#pragma unroll
                for (int e = 0; e < 4; ++e) { const f32x4 wv = *(const f32x4*)(w4s + (i4 * 4 + e) * 4); a0 += h[e] * wv[0]; a1 += h[e] * wv[1]; a2 += h[e] * wv[2]; a3 += h[e] * wv[3]; }
            }
            const float tt = (float)pos / (float)(L - 1);
            const float hf1 = a0 * __expf(-tt * d00), hf2 = a1 * __expf(-tt * d01), hb1 = a2 * __expf(-tt * d10), hb2 = a3 * __expf(-tt * d11);
            if (pos == 0) { buf[0] = make_float2(hf1 + hb1, hf2 + hb2); buf[PIX(L)] = make_float2(0.f, 0.f); }
            else { buf[PIX(pos)] = make_float2(hf1, hf2); buf[PIX(N - pos)] = make_float2(hb1, hb2); }
        }
        __syncthreads();
        fft_fwd<LOGN, 1>(buf, tid);
        const float sc = 0.25f / (float)N;
        float2* K1 = KF + (size_t)l * KF_LAYER + (Lsel ? (size_t)512 * KS4 + (size_t)(2 * cp) * KS2 : (size_t)(2 * cp) * KS4);
        float2* K2 = K1 + (Lsel ? KS2 : KS4);
#pragma nounroll
        for (int k = tid; k <= L; k += 512) {
            const int pa = (int)(__brev((unsigned)k) >> (32 - logN)), pb = (int)(__brev((unsigned)((N - k) & (N - 1))) >> (32 - logN));
            const float2 a = buf[PIX(pa)], b = buf[PIX(pb)];
            K1[k] = make_float2((a.x + b.x) * sc, (a.y - b.y) * sc);
            K2[k] = make_float2((a.y + b.y) * sc, -(a.x - b.x) * sc);
        }
        __syncthreads();
    }
}

__device__ __forceinline__ void phase0b(const Params& p, unsigned char* smem) {
    const int zl = launder0(); unsigned char* const wsp = lptr(p.ws); float* const xp = lptr(p.X); (void)xp;
    const int tid = ltid(), lane = tid & 63, w = tid >> 6;
    float2* buf = (float2*)smem; float* w4s = (float*)(smem + 69632);
    const float* H3 = (const float*)(wsp + OFF_H3);
    float2* KF = (float2*)(wsp + OFF_KF);
    for (int v = blockIdx.x; v < 2048; v += gridDim.x) {
        const int l = v >> 9, ww = v & 511, cp = ww & 255;
        if (ww >> 8) filt_unit<12>(p, l, cp, smem, zl, wsp); else filt_unit<13>(p, l, cp, smem, zl, wsp);
    }
    {
        const float* MOD = (const float*)(wsp + OFF_MOD);
        bf16_t* H = (bf16_t*)(wsp + OFF_H);
        for (int row = blockIdx.x * 8 + w; row < MTOT; row += gridDim.x * 8) {
            const float* src = row < 65536 ? PIN[0] + (size_t)row * 1024 : PIN[1] + (size_t)(row - 65536) * 1024;
            const float* md = MOD + (size_t)row_bidx(row) * 9216;
#pragma unroll
            for (int i = 0; i < 4; ++i) {
                const int col = i * 256 + lane * 4;
                const f32x4 v = *(const f32x4*)(src + col), sh = *(const f32x4*)(md + col), scl = *(const f32x4*)(md + 1024 + col);
                *(f32x4*)(xp + (size_t)row * 1024 + col) = v;
                const f32x4 h = v * (scl + 1.0f) + sh;
                u32x2 pk; pk[0] = pk2(h[0], h[1]); pk[1] = pk2(h[2], h[3]);
                *(u32x2*)(H + (size_t)row * 1024 + col) = pk;
            }
        }
    }
}

__device__ __forceinline__ void lnmod_phase(unsigned char* wsp, float* xp, const float* __restrict__ g, const float* __restrict__ bb, const float* __restrict__ modbase, bool write_x) {
    const int tid = ltid(), lane = tid & 63, w = tid >> 6;
    bf16_t* H = (bf16_t*)(wsp + OFF_H);
    float2* stats = (float2*)(wsp + OFF_STATS);
    constexpr int NR = 4;
    for (int rp = blockIdx.x * 8 + w; rp < MTOT / NR; rp += gridDim.x * 8) {
        const int row = rp * NR;
        float* xr = xp + (size_t)row * 1024;
        f32x4 v[NR][4];
#pragma unroll
        for (int r2 = 0; r2 < NR; ++r2)
#pragma unroll
            for (int i = 0; i < 4; ++i) v[r2][i] = *(const f32x4*)(xr + r2 * 1024 + i * 256 + lane * 4);
        float mean[NR], rstd[NR];
#pragma unroll
        for (int r2 = 0; r2 < NR; ++r2) {
            float s = 0.f;
#pragma unroll
            for (int i = 0; i < 4; ++i) s += v[r2][i][0] + v[r2][i][1] + v[r2][i][2] + v[r2][i][3];
            mean[r2] = s;
        }
#pragma unroll
        for (int o = 1; o < 64; o <<= 1)
#pragma unroll
            for (int r2 = 0; r2 < NR; ++r2) mean[r2] += __shfl_xor(mean[r2], o);
#pragma unroll
        for (int r2 = 0; r2 < NR; ++r2) {
            mean[r2] *= (1.0f / 1024.0f);
            float q = 0.f;
#pragma unroll
            for (int i = 0; i < 4; ++i) { const f32x4 d = v[r2][i] - mean[r2]; q += d[0] * d[0] + d[1] * d[1] + d[2] * d[2] + d[3] * d[3]; }
            rstd[r2] = q;
        }
#pragma unroll
        for (int o = 1; o < 64; o <<= 1)
#pragma unroll
            for (int r2 = 0; r2 < NR; ++r2) rstd[r2] += __shfl_xor(rstd[r2], o);
#pragma unroll
        for (int r2 = 0; r2 < NR; ++r2) {
            rstd[r2] = rsqrtf(rstd[r2] * (1.0f / 1024.0f) + 1e-5f);
            if (lane == 0) stats[row + r2] = make_float2(mean[r2], rstd[r2]);
        }
        const float* md = modbase ? modbase + (size_t)row_bidx(row) * 9216 : nullptr;
#pragma unroll
        for (int i = 0; i < 4; ++i) {
            const int col = i * 256 + lane * 4;
            const f32x4 gg = *(const f32x4*)(g + col), be = *(const f32x4*)(bb + col);
            f32x4 sh = {0.f, 0.f, 0.f, 0.f}, scl = {0.f, 0.f, 0.f, 0.f};
            if (md) { sh = *(const f32x4*)(md + col); scl = *(const f32x4*)(md + 1024 + col); }
#pragma unroll
            for (int r2 = 0; r2 < NR; ++r2) {
                const f32x4 xn = (v[r2][i] - mean[r2]) * rstd[r2] * gg + be;
                if (write_x) *(f32x4*)(xr + r2 * 1024 + col) = xn;
                if (md) {
                    const f32x4 h = xn * (scl + 1.0f) + sh;
                    u32x2 pk; pk[0] = pk2(h[0], h[1]); pk[1] = pk2(h[2], h[3]);
                    *(u32x2*)(H + (size_t)(row + r2) * 1024 + col) = pk;
                }
            }
        }
    }
}

__device__ __forceinline__ u32x4 rope_apply(u32x4 mine, u32x4 other, const f32x4 (&cs)[4], int second) {
    u32x4 out;
#pragma unroll
    for (int q = 0; q < 4; ++q) {
        const float m0 = bf_lo(mine[q]), m1 = bf_hi(mine[q]), o0 = bf_lo(other[q]), o1 = bf_hi(other[q]);
        const float r0 = second ? m0 * cs[q][0] + o0 * cs[q][1] : m0 * cs[q][0] - o0 * cs[q][1];
        const float r1 = second ? m1 * cs[q][2] + o1 * cs[q][3] : m1 * cs[q][2] - o1 * cs[q][3];
        out[q] = pk2(r0, r1);
    }
    return out;
}

__device__ __forceinline__ void attn_unit(const Params& p, int l, int ua, unsigned char* smem) {
    const int zl = launder0(); unsigned char* const wsp = lptr(p.ws); float* const xp = lptr(p.X); (void)xp;
    const int tid = ltid(), lane = tid & 63, w = tid >> 6;
    const int qb = ua >> 1, g = ua & 1;
    int blk, nb;
    if (qb < 512) { blk = qb & 31; nb = 32; } else { blk = (qb - 512) & 15; nb = 16; }
    const int row0 = qb * 128, pos0 = blk * 128;
    const bool hasPrev = blk > 0, hasNext = blk < nb - 1;
    const bf16_t* ZA = (const bf16_t*)(wsp + OFF_ZA);
    const bf16_t* ZT = (const bf16_t*)(wsp + OFF_ZT);
    bf16_t* A2 = (bf16_t*)(wsp + OFF_H);
    const float2* rope = (const float2*)(wsp + OFF_ROPE);
    unsigned char* Ks = smem;
    unsigned char* Vs = smem + 55296;
    {
        u32x4 kv[5], vv[6], k0 = {0u, 0u, 0u, 0u}, k1 = {0u, 0u, 0u, 0u};
        f32x4 cs[4];
#pragma unroll
        for (int q = 0; q < 4; ++q) cs[q] = (f32x4){1.f, 0.f, 1.f, 0.f};
#pragma unroll
        for (int i = 0; i < 5; ++i) {
            const int idx = tid + 512 * i, kb = idx / 6, part = 2 + idx % 6, b3 = kb >> 7;
            const bool valid = (idx < 2304) && ((b3 == 1) || (b3 == 0 && hasPrev) || (b3 == 2 && hasNext));
            kv[i] = (u32x4){0u, 0u, 0u, 0u};
            if (valid) kv[i] = *(const u32x4*)(ZA + (size_t)(row0 - 128 + kb) * 768 + 512 + g * 64 + part * 8);
        }
#pragma unroll
        for (int i = 0; i < 6; ++i) {
            const int idx = tid + 512 * i, d = idx / 48, part = idx % 48, kb0 = part * 8, b3 = kb0 >> 7;
            const bool valid = (b3 == 1) || (b3 == 0 && hasPrev) || (b3 == 2 && hasNext);
            vv[i] = (u32x4){0u, 0u, 0u, 0u};
            if (valid) vv[i] = *(const u32x4*)(ZT + (size_t)(1536 + g * 64 + d) * MTOT + row0 - 128 + kb0);
        }
        const int rkb = tid, rb3 = rkb >> 7;
        const bool rvalid = (rkb < 384) && ((rb3 == 1) || (rb3 == 0 && hasPrev) || (rb3 == 2 && hasNext));
        if (rvalid) {
            const bf16_t* src = ZA + (size_t)(row0 - 128 + rkb) * 768 + 512 + g * 64;
            k0 = *(const u32x4*)src; k1 = *(const u32x4*)(src + 8);
            const f32x4* tp = (const f32x4*)(rope + (size_t)(pos0 - 128 + rkb) * 8);
#pragma unroll
            for (int q = 0; q < 4; ++q) cs[q] = tp[q];
        }
#pragma unroll
        for (int i = 0; i < 5; ++i) { const int idx = tid + 512 * i, kb = idx / 6, part = 2 + idx % 6; if (idx < 2304) *(u32x4*)(Ks + kb * 144 + part * 16) = kv[i]; }
#pragma unroll
        for (int i = 0; i < 6; ++i) { const int idx = tid + 512 * i, d = idx / 48, part = idx % 48; *(u32x4*)(Vs + d * 784 + part * 16) = vv[i]; }
        if (rkb < 384) {
            const u32x4 r0 = rope_apply(k0, k1, cs, 0), r1 = rope_apply(k1, k0, cs, 1);
            *(u32x4*)(Ks + rkb * 144) = r0; *(u32x4*)(Ks + rkb * 144 + 16) = r1;
        }
    }
    __syncthreads();
    const int hh = w >> 1, head = g * 4 + hh;
    const float sinkv = PIN[14][l * 8 + head];
    const int r = lane & 31, h = lane >> 5;
    for (int qt = 0; qt < 2; ++qt) {
        const int qi = (w & 1) * 2 + qt;
        const int qrow = row0 + 32 * qi + r, qpos = pos0 + 32 * qi + r;
        const bf16_t* qsrc = ZA + (size_t)qrow * 768 + head * 64;
        bf16x8 qf[4];
        {
            u32x4 qv[4]; f32x4 cs[4];
#pragma unroll
            for (int s = 0; s < 4; ++s) qv[s] = *(const u32x4*)(qsrc + 16 * s + 8 * h);
            const u32x4 qo = *(const u32x4*)(qsrc + 8 * (1 - h));
            const f32x4* tp = (const f32x4*)(rope + (size_t)qpos * 8);
#pragma unroll
            for (int q = 0; q < 4; ++q) cs[q] = tp[q];
            qv[0] = rope_apply(qv[0], qo, cs, h);
#pragma unroll
            for (int s = 0; s < 4; ++s) {
#pragma unroll
                for (int q = 0; q < 4; ++q) qv[s][q] = pk2(bf_lo(qv[s][q]) * 0.125f, bf_hi(qv[s][q]) * 0.125f);
                qf[s] = __builtin_bit_cast(bf16x8, qv[s]);
            }
        }
        float mrun = sinkv, lsum = 1.0f;
        f32x16 O[2];
#pragma unroll
        for (int dt = 0; dt < 2; ++dt)
#pragma unroll
            for (int e = 0; e < 16; ++e) O[dt][e] = 0.f;
#pragma nounroll
        for (int ch = 0; ch < 3; ++ch) {
            f32x16 S[3];
#pragma unroll
            for (int c = 0; c < 3; ++c) {
#pragma unroll
                for (int e = 0; e < 16; ++e) S[c][e] = 0.f;
                const unsigned char* kp = Ks + (32 * (qi + 3 * ch + c) + r) * 144 + h * 16;
#pragma unroll
                for (int s = 0; s < 4; ++s) { const bf16x8 kf = *(const bf16x8*)(kp + s * 32); S[c] = __builtin_amdgcn_mfma_f32_32x32x16_bf16(kf, qf[s], S[c], 0, 0, 0); }
            }
            float cmax = -1e30f;
#pragma unroll
            for (int c = 0; c < 3; ++c) {
                const int tp = 3 * ch + c, b3 = (qi + tp) >> 2;
                const bool tv = (b3 == 1) || (b3 == 0 && hasPrev) || (b3 == 2 && hasNext);
#pragma unroll
                for (int e = 0; e < 16; ++e) {
                    const int kk = (e & 3) + 8 * (e >> 2) + 4 * h;
                    bool ok = tv;
                    if (c == 0) ok = ok && (tp != 0 || kk >= r);
                    if (c == 2) ok = ok && (tp != 8 || kk <= r);
                    const float sv = ok ? S[c][e] : -1e30f;
                    S[c][e] = sv; cmax = fmaxf(cmax, sv);
                }
            }
            cmax = fmaxf(cmax, __shfl_xor(cmax, 32));
            const float mnew = fmaxf(mrun, cmax), scl = __expf(mrun - mnew);
            mrun = mnew;
            float psum = 0.f;
#pragma unroll
            for (int c = 0; c < 3; ++c)
#pragma unroll
                for (int e = 0; e < 16; ++e) { const float pv = __expf(S[c][e] - mnew); S[c][e] = pv; psum += pv; }
            psum += __shfl_xor(psum, 32);
            lsum = lsum * scl + psum;
#pragma unroll
            for (int dt = 0; dt < 2; ++dt)
#pragma unroll
                for (int e = 0; e < 16; ++e) O[dt][e] *= scl;
#pragma unroll
            for (int c = 0; c < 3; ++c)
#pragma unroll
                for (int s2 = 0; s2 < 2; ++s2) {
                    u32x4 pp; pp[0] = pk2(S[c][8 * s2 + 0], S[c][8 * s2 + 1]); pp[1] = pk2(S[c][8 * s2 + 2], S[c][8 * s2 + 3]); pp[2] = pk2(S[c][8 * s2 + 4], S[c][8 * s2 + 5]); pp[3] = pk2(S[c][8 * s2 + 6], S[c][8 * s2 + 7]);
                    const bf16x8 pf = __builtin_bit_cast(bf16x8, pp);
#pragma unroll
                    for (int dt = 0; dt < 2; ++dt) {
                        const unsigned char* vp = Vs + (32 * dt + r) * 784 + (32 * (qi + 3 * ch + c) + 16 * s2 + 4 * h) * 2;
                        const u32x2 lo = *(const u32x2*)vp, hi = *(const u32x2*)(vp + 16);
                        u32x4 vv; vv[0] = lo[0]; vv[1] = lo[1]; vv[2] = hi[0]; vv[3] = hi[1];
                        O[dt] = __builtin_amdgcn_mfma_f32_32x32x16_bf16(__builtin_bit_cast(bf16x8, vv), pf, O[dt], 0, 0, 0);
                    }
                }
        }
        const float inv = 1.0f / lsum;
        bf16_t* op = A2 + (size_t)qrow * 1024 + head * 64;
#pragma unroll
        for (int dt = 0; dt < 2; ++dt)
#pragma unroll
            for (int gq = 0; gq < 4; ++gq) {
                u32x2 o; o[0] = pk2(O[dt][4 * gq + 0] * inv, O[dt][4 * gq + 1] * inv); o[1] = pk2(O[dt][4 * gq + 2] * inv, O[dt][4 * gq + 3] * inv);
                *(u32x2*)(op + 32 * dt + 8 * gq + 4 * h) = o;
            }
    }
    __syncthreads();
}

template <int LOGN>
__device__ __forceinline__ void hyena_unit(const Params& p, int l, int hu, unsigned char* smem, bool dry = false) {
    const int zl = launder0(); unsigned char* const wsp = lptr(p.ws);
    const int tid = ltid();
    constexpr int L = 1 << (LOGN - 1), logN = LOGN, N = 2 * L;
    const int bidx = (LOGN == 13 ? 0 : 16) + (hu >> 7), cq = hu & 127;
    const size_t rb = bidx < 16 ? (size_t)bidx * 4096 : 65536 + (size_t)(bidx - 16) * 2048;
    float2* buf = (float2*)smem;
    bf16_t* ZT = (bf16_t*)(wsp + OFF_ZT);
    const float* cw = PIN[16] + (size_t)l * 3 * 1536; const float* cb = PIN[17] + (size_t)l * 1536;
    const int t8 = tid * 8; const bool act = t8 < L;
    float u[2][2][8], x0c[2][2][8];
    if (act) {
        u32x4 raw[2][2][3]; bf16_t pvr[2][2][3], nxr[2][2][3];
        const int po = t8 > 0 ? -1 : 0, no = (t8 + 8 < L) ? 8 : 7;
#pragma unroll
        for (int pp = 0; pp < 2; ++pp)
#pragma unroll
            for (int cc = 0; cc < 2; ++cc)
#pragma unroll
                for (int gi = 0; gi < 3; ++gi) {
                    const bf16_t* src = ZT + (size_t)(gi * 512 + 4 * cq + 2 * pp + cc) * MTOT + rb + t8;
                    raw[pp][cc][gi] = *(const u32x4*)src; pvr[pp][cc][gi] = src[po]; nxr[pp][cc][gi] = src[no];
                }
#pragma unroll
        for (int pp = 0; pp < 2; ++pp) {
            const int c1 = 4 * cq + 2 * pp;
#pragma unroll
            for (int cc = 0; cc < 2; ++cc) {
                float cv[3][8];
#pragma unroll
                for (int gi = 0; gi < 3; ++gi) {
                    const int col = gi * 512 + c1 + cc;
                    float in[10];
                    in[0] = t8 > 0 ? bf2f(pvr[pp][cc][gi]) : 0.f;
                    in[9] = (t8 + 8 < L) ? bf2f(nxr[pp][cc][gi]) : 0.f;
#pragma unroll
                    for (int q = 0; q < 4; ++q) { in[1 + 2 * q] = bf_lo(raw[pp][cc][gi][q]); in[2 + 2 * q] = bf_hi(raw[pp][cc][gi][q]); }
                    const float w0 = cw[col], w1 = cw[1536 + col], w2 = cw[3072 + col], bsv = cb[col];
#pragma unroll
                    for (int j = 0; j < 8; ++j) cv[gi][j] = w0 * in[j] + w1 * in[j + 1] + w2 * in[j + 2] + bsv;
                }
#pragma unroll
                for (int j = 0; j < 8; ++j) { u[pp][cc][j] = cv[2][j] * cv[1][j]; x0c[pp][cc][j] = cv[0][j]; }
            }
            float2* bb = buf + pp * FFT_BUF_STRIDE;
#pragma unroll
            for (int j = 0; j < 8; ++j) { bb[PIX(t8 + j)] = make_float2(u[pp][0][j], u[pp][1][j]); bb[PIX(L + t8 + j)] = make_float2(0.f, 0.f); }
        }
    }
    __syncthreads();
    fft_fwd<LOGN, 2>(buf, tid);
    {
        const float2* KF = (const float2*)(wsp + OFF_KF);
#pragma unroll
        for (int pp = 0; pp < 2; ++pp) {
            const int c1 = 4 * cq + 2 * pp;
            const float2* K1 = KF + (size_t)l * KF_LAYER + (bidx < 16 ? (size_t)c1 * KS4 : (size_t)512 * KS4 + (size_t)c1 * KS2);
            const float2* K2 = K1 + (bidx < 16 ? KS4 : KS2);
            float2* bb = buf + pp * FFT_BUF_STRIDE;
#pragma unroll
            for (int i = 0; i < 9; ++i) {
                const int k = tid + 512 * i; if (k > L) continue;
                const int pa = (int)(__brev((unsigned)k) >> (32 - logN)), pb = (int)(__brev((unsigned)((N - k) & (N - 1))) >> (32 - logN));
                const float2 a = bb[PIX(pa)], b = bb[PIX(pb)];
                const float u1x = a.x + b.x, u1y = a.y - b.y, u2x = a.y + b.y, u2y = b.x - a.x;
                const float2 k1 = K1[k], k2 = K2[k];
                const float p1x = u1x * k1.x - u1y * k1.y, p1y = u1x * k1.y + u1y * k1.x;
                const float p2x = u2x * k2.x - u2y * k2.y, p2y = u2x * k2.y + u2y * k2.x;
                bb[PIX(pa)] = make_float2(p1x - p2y, p1y + p2x);
                if (pb != pa) bb[PIX(pb)] = make_float2(p1x + p2y, p2x - p1y);
            }
        }
    }
    __syncthreads();
    fft_inv<LOGN, 2>(buf, tid);
    if (act) {
#pragma unroll
        for (int pp = 0; pp < 2; ++pp) {
            const int c1 = 4 * cq + 2 * pp;
            const float2* bb = buf + pp * FFT_BUF_STRIDE;
#pragma unroll
            for (int cc = 0; cc < 2; ++cc) {
                const float bias = PIN[27][l * 512 + c1 + cc];
                float o[8];
#pragma unroll
                for (int j = 0; j < 8; ++j) { const float2 y = bb[PIX(t8 + j)]; o[j] = ((cc ? y.y : y.x) + u[pp][cc][j] * bias) * x0c[pp][cc][j]; }
                u32x4 pk; pk[0] = pk2(o[0], o[1]); pk[1] = pk2(o[2], o[3]); pk[2] = pk2(o[4], o[5]); pk[3] = pk2(o[6], o[7]);
                if (!dry) *(u32x4*)(ZT + (size_t)(c1 + cc) * MTOT + rb + t8) = pk;
            }
        }
    }
    __syncthreads();
}

__device__ __forceinline__ void rms_unit(const Params& p, int l, int rc, unsigned char* smem) {
    const int zl = launder0(); unsigned char* const wsp = lptr(p.ws); float* const xp = lptr(p.X); (void)xp;
    const int tid = ltid(), lane = tid & 63, w = tid >> 6;
    const int row0 = rc * 64;
    bf16_t* A2 = (bf16_t*)(wsp + OFF_H);
    const bf16_t* ZT = (const bf16_t*)(wsp + OFF_ZT);
    const float* gn = PIN[15] + (size_t)l * 1024;
    {
        const f32x4 g0 = *(const f32x4*)(gn + lane * 8), g1 = *(const f32x4*)(gn + lane * 8 + 4);
        bf16_t* ap = A2 + (size_t)(row0 + w * 8) * 1024 + lane * 8;
        u32x4 va[8]; float ss[8];
#pragma unroll
        for (int rr = 0; rr < 8; ++rr) va[rr] = *(const u32x4*)(ap + (size_t)rr * 1024);
#pragma unroll
        for (int rr = 0; rr < 8; ++rr) {
            float a = 0.f;
#pragma unroll
            for (int q = 0; q < 4; ++q) { const float lo = bf_lo(va[rr][q]), hi = bf_hi(va[rr][q]); a += lo * lo + hi * hi; }
            ss[rr] = a;
        }
#pragma unroll
        for (int o = 1; o < 64; o <<= 1)
#pragma unroll
            for (int rr = 0; rr < 8; ++rr) ss[rr] += __shfl_xor(ss[rr], o);
#pragma unroll
        for (int rr = 0; rr < 8; ++rr) {
            const float rstd = rsqrtf(ss[rr] * (1.0f / 512.0f) + 1e-6f);
            u32x4 pk;
            pk[0] = pk2(bf_lo(va[rr][0]) * rstd * g0[0], bf_hi(va[rr][0]) * rstd * g0[1]); pk[1] = pk2(bf_lo(va[rr][1]) * rstd * g0[2], bf_hi(va[rr][1]) * rstd * g0[3]);
            pk[2] = pk2(bf_lo(va[rr][2]) * rstd * g1[0], bf_hi(va[rr][2]) * rstd * g1[1]); pk[3] = pk2(bf_lo(va[rr][3]) * rstd * g1[2], bf_hi(va[rr][3]) * rstd * g1[3]);
            *(u32x4*)(ap + (size_t)rr * 1024) = pk;
        }
    }
    bf16_t* T = (bf16_t*)smem;
    {
        const int c = tid;
        u32x4 vv[8];
#pragma unroll
        for (int q = 0; q < 8; ++q) vv[q] = *(const u32x4*)(ZT + (size_t)c * MTOT + row0 + q * 8);
#pragma unroll
        for (int q = 0; q < 8; ++q)
#pragma unroll
            for (int e = 0; e < 4; ++e) { T[(q * 8 + 2 * e) * 520 + c] = (bf16_t)(vv[q][e] & 0xffffu); T[(q * 8 + 2 * e + 1) * 520 + c] = (bf16_t)(vv[q][e] >> 16); }
    }
    __syncthreads();
    {
        const f32x4 g0 = *(const f32x4*)(gn + 512 + lane * 8), g1 = *(const f32x4*)(gn + 512 + lane * 8 + 4);
        u32x4 va[8]; float ss[8];
#pragma unroll
        for (int rr = 0; rr < 8; ++rr) va[rr] = *(const u32x4*)(T + (w * 8 + rr) * 520 + lane * 8);
#pragma unroll
        for (int rr = 0; rr < 8; ++rr) {
            float a = 0.f;
#pragma unroll
            for (int q = 0; q < 4; ++q) { const float lo = bf_lo(va[rr][q]), hi = bf_hi(va[rr][q]); a += lo * lo + hi * hi; }
            ss[rr] = a;
        }
#pragma unroll
        for (int o = 1; o < 64; o <<= 1)
#pragma unroll
            for (int rr = 0; rr < 8; ++rr) ss[rr] += __shfl_xor(ss[rr], o);
#pragma unroll
        for (int rr = 0; rr < 8; ++rr) {
            const float rstd = rsqrtf(ss[rr] * (1.0f / 512.0f) + 1e-6f);
            u32x4 pk;
            pk[0] = pk2(bf_lo(va[rr][0]) * rstd * g0[0], bf_hi(va[rr][0]) * rstd * g0[1]); pk[1] = pk2(bf_lo(va[rr][1]) * rstd * g0[2], bf_hi(va[rr][1]) * rstd * g0[3]);
            pk[2] = pk2(bf_lo(va[rr][2]) * rstd * g1[0], bf_hi(va[rr][2]) * rstd * g1[1]); pk[3] = pk2(bf_lo(va[rr][3]) * rstd * g1[2], bf_hi(va[rr][3]) * rstd * g1[3]);
            *(u32x4*)(A2 + (size_t)(row0 + w * 8 + rr) * 1024 + 512 + lane * 8) = pk;
        }
    }
    __syncthreads();
}

#define LAS __attribute__((address_space(3)))
#define XB_TMO      128
#define XB_XCNT(j)  (256  + 64 * (j))
#define XB_XSUB(j)  (1280 + 64 * (j))
#define XB_XGEN(j)  (2304 + 64 * (j))
#define XB_TOP      3328
#define XB_TOPGEN   3392
#define XCD_BAR_WORDS 3456
#define XB_SPIN_CAP (1u << 18)

__device__ __forceinline__ unsigned xb_ld(unsigned* p)              { return __hip_atomic_load(p, __ATOMIC_RELAXED, __HIP_MEMORY_SCOPE_AGENT); }
__device__ __forceinline__ unsigned xb_add(unsigned* p, unsigned v) { return __hip_atomic_fetch_add(p, v, __ATOMIC_RELAXED, __HIP_MEMORY_SCOPE_AGENT); }
__device__ __forceinline__ unsigned xb_xcc_id() { return (unsigned)__builtin_amdgcn_s_getreg((3 << 11) | 20) & 0xFu; }
#define XB_SPIN(cond, bar) do { unsigned _sp = 0; while (cond) { __builtin_amdgcn_s_sleep(1); \
    if ((++_sp & 255u) == 0u) { if (xb_ld(&(bar)[XB_TMO])) break; if (_sp > XB_SPIN_CAP) { atomicAdd(&(bar)[XB_TMO], 1u); break; } } } } while (0)

struct XcdBarrier {
    unsigned* bar; unsigned x;
    volatile LAS unsigned* st;
};

__device__ __forceinline__ XcdBarrier xcd_barrier_post(unsigned* bar, volatile LAS unsigned* st) {
    XcdBarrier b; b.bar = bar; b.x = xb_xcc_id(); b.st = st;
    if (threadIdx.x == 0) (void)xb_add(&bar[XB_XCNT(b.x)], 1u);
    return b;
}
__device__ __forceinline__ void xcd_barrier_complete(unsigned* bar, unsigned x, unsigned& nloc, unsigned& nx) {
    const unsigned G = gridDim.x * gridDim.y * gridDim.z;
    unsigned sum, cnt, mine, sp = 0u;
    for (;;) {
        sum = 0u; cnt = 0u; mine = 0u;
#pragma unroll
        for (unsigned j = 0; j < 16; ++j) { const unsigned c = xb_ld(&bar[XB_XCNT(j)]); sum += c; cnt += (c > 0u) ? 1u : 0u; mine = (j == x) ? c : mine; }
        if (sum == G) break;
        __builtin_amdgcn_s_sleep(1);
        if ((++sp & 255u) == 0u) { if (xb_ld(&bar[XB_TMO])) break; if (sp > XB_SPIN_CAP) { atomicAdd(&bar[XB_TMO], 1u); break; } }
    }
    nloc = mine > 0u ? mine : 1u; nx = cnt > 0u ? cnt : 1u;
}

__device__ __forceinline__ void xcd_barrier(const XcdBarrier& b) {
    asm volatile("s_waitcnt vmcnt(0)" ::: "memory");
    __syncthreads();
    if (threadIdx.x == 0) {
        unsigned* bar = b.bar;
        __builtin_amdgcn_s_waitcnt(0);
        unsigned nloc = b.st[0], nx = b.st[1];
        if (nloc == 0u) { xcd_barrier_complete(bar, b.x, nloc, nx); b.st[0] = nloc; b.st[1] = nx; }
        const unsigned old = xb_add(&bar[XB_XSUB(b.x)], 1u);
        const unsigned gen = old / nloc;
        if (old + 1u == (gen + 1u) * nloc) {
            __builtin_amdgcn_fence(__ATOMIC_RELEASE, "agent");
            asm volatile("s_waitcnt vmcnt(0)" ::: "memory");
            const unsigned og = xb_add(&bar[XB_TOP], 1u);
            const unsigned tg = og / nx;
            if (og + 1u == (tg + 1u) * nx) xb_add(&bar[XB_TOPGEN], 1u);
            else XB_SPIN(xb_ld(&bar[XB_TOPGEN]) == tg, bar);
            __builtin_amdgcn_fence(__ATOMIC_ACQUIRE, "agent");
            xb_add(&bar[XB_XGEN(b.x)], 1u);
            asm volatile("s_waitcnt vmcnt(0)" ::: "memory");
        } else {
            XB_SPIN(xb_ld(&bar[XB_XGEN(b.x)]) == gen, bar);
            __builtin_amdgcn_fence(__ATOMIC_ACQUIRE, "agent");
            asm volatile("s_waitcnt vmcnt(0)" ::: "memory");
        }
    }
    __syncthreads();
}

__global__ void __launch_bounds__(512) hymba_fwd(Params p) {
    extern __shared__ __attribute__((aligned(16))) unsigned char smem[];
    cg::grid_group grid = cg::this_grid();
    volatile LAS unsigned* bst = (volatile LAS unsigned*)(smem + 135168 + 512);
    if (threadIdx.x < 2) bst[threadIdx.x] = 0u;
    __syncthreads();
    XcdBarrier xbar = xcd_barrier_post((unsigned*)(p.ws + OFF_BAR), bst);
    PG8_LAS unsigned char* lds = (PG8_LAS unsigned char*)smem;
    const int G = gridDim.x, wg = blockIdx.x;
    for (int ph = p.ph_lo; ph < p.ph_hi; ++ph) {
        const int zl = launder0(); unsigned char* const wsp = lptr(p.ws); float* const xp = lptr(p.X);
        bf16_t* Hb = (bf16_t*)(wsp + OFF_H); bf16_t* ACT = (bf16_t*)(wsp + OFF_ACT); float* MOD = (float*)(wsp + OFF_MOD);
#ifdef PROBE_P0
        if (ph == 0) { phase0a(p, smem); __syncthreads(); }
        if (ph == 1) { phase0b(p, smem); __syncthreads(); }
#endif
        if (EN_P0 && ph == 0) phase0a(p, smem);
        else if (EN_P1 && ph == 1) phase0b(p, smem);
        else {
            const int l = (ph - 2) / 11, s = (ph - 2) % 11;
            const bf16_t* wl = (const bf16_t*)(wsp + OFF_W) + (size_t)l * WL_ELEMS;
            if (EN_GEMM && (s == 0 || s == 8 || s == 1 || s == 9 || s == 3 || s == 6)) {
                const int nsub = (s == 3) ? 2 : 1;
                for (int sub = 0; sub < nsub; ++sub) {
                    pg8::Gemm g; pg8::EpiAny E;
                    E.O = ACT; E.ldc = 2816; E.X = xp; E.gate = MOD; E.coef = 0.5f; E.mode = 0; E.perm = true;
                    E.stats = (const float2*)(wsp + OFF_STATS); E.lng = nullptr; E.lnb = nullptr;
                    if (s == 0 || s == 8) { g.A = Hb; g.Bt = wl + (s ? WO_WI2 : WO_WI1); g.M = MTOT; g.N = 5632; g.K = 1024; }
                    else if (s == 1 || s == 9) { g.A = ACT; g.Bt = wl + (s == 9 ? WO_WO2 : WO_WO1); g.M = MTOT; g.N = 1024; g.K = 2816;
                        E.mode = 1; E.perm = false; E.gate = MOD + (size_t)l * 32 * 9216 + (s == 9 ? 8 : 2) * 1024;
                        const int lnrow = (s == 9) ? l * 3 + 1 : l * 3 - 1;
                        if (lnrow >= 0) { E.lng = PIN[10] + (size_t)lnrow * 1024; E.lnb = PIN[11] + (size_t)lnrow * 1024; } }
                    else if (s == 6) { g.A = Hb; g.Bt = wl + WO_WOUT; g.M = MTOT; g.N = 1024; g.K = 1024;
                        E.mode = 1; E.perm = false; E.gate = MOD + (size_t)l * 32 * 9216 + 5 * 1024; E.coef = 1.0f;
                        E.lng = PIN[10] + (size_t)(l * 3) * 1024; E.lnb = PIN[11] + (size_t)(l * 3) * 1024; }
                    else if (sub == 0) { g.A = Hb; g.Bt = wl + WO_WINA; g.M = MTOT; g.N = 768; g.K = 1024; E.mode = 2; E.O = (bf16_t*)(wsp + OFF_ZA); E.ldc = 768; }
                    else { g.A = wl + WO_WINB; g.Bt = Hb; g.M = 1792; g.N = MTOT; g.K = 1024; E.mode = 2; E.O = (bf16_t*)(wsp + OFF_ZT); E.ldc = (size_t)MTOT; }
                    pg8::StaticOrder S; S.init(g.M, g.N, G, (s == 3 && sub == 1) ? G - 1 - wg : wg);
                    pg8::gemm_phase<pg8::EpiAny, pg8::StaticOrder, GEMM_ALIGN, GEMM_SP2>(lds, g, S, E);
                }
            } else if (EN_LN && (s == 2 || s == 7 || s == 10)) {
                const int li = s == 2 ? 0 : (s == 7 ? 1 : 2);
                const float* md = nullptr;
                if (s == 2) md = MOD + (size_t)l * 32 * 9216 + 3 * 1024;
                else if (s == 7) md = MOD + (size_t)l * 32 * 9216 + 6 * 1024;
                else if (l + 1 < NLAYER) md = MOD + (size_t)(l + 1) * 32 * 9216;
#ifdef PROBE_LN
                if (md) lnmod_phase(wsp, xp, PIN[10] + (size_t)(l * 3 + li) * 1024, PIN[11] + (size_t)(l * 3 + li) * 1024, md, md == nullptr);
#endif
                lnmod_phase(wsp, xp, PIN[10] + (size_t)(l * 3 + li) * 1024, PIN[11] + (size_t)(l * 3 + li) * 1024, md, md == nullptr);
            } else if (s == 4) {
#ifdef PROBE_ATT
                for (int ua = wg; ua < 1536; ua += G) attn_unit(p, l, ua, smem);
#endif
#ifdef PROBE_HY
                { for (int hu = wg; hu < 2048; hu += G) hyena_unit<13>(p, l, hu, smem, launder0() == 0); for (int hu = wg; hu < 2048; hu += G) hyena_unit<12>(p, l, hu, smem, launder0() == 0); }
#endif
                if (EN_ATT) for (int ua = wg; ua < 1536; ua += G) attn_unit(p, l, ua, smem);
                if (EN_HY) { for (int hu = wg; hu < 2048; hu += G) hyena_unit<13>(p, l, hu, smem); for (int hu = wg; hu < 2048; hu += G) hyena_unit<12>(p, l, hu, smem); }
            } else if (EN_RMS && s == 5) {
                for (int rc = wg; rc < 1536; rc += G) rms_unit(p, l, rc, smem);
            }
        }
#ifdef PROBE_SYNC
        if (ph + 1 < p.ph_hi) { grid.sync(); grid.sync(); grid.sync(); }
#endif
        if (ph + 1 < p.ph_hi) { if (ph == 0) grid.sync(); else xcd_barrier(xbar); }
    }
}

extern "C" void kernel_launch(void* const* d_in, const int* in_sizes, int n_in, void* d_out, int out_size, void* d_ws, size_t ws_size, hipStream_t stream) {
    static int grid = 0;
    if (grid == 0) {
        if (n_in != 28 || ws_size < WS_NEED) { fprintf(stderr, "kernel_launch: unexpected n_in %d or ws_size %zu (need %zu)\n", n_in, ws_size, (size_t)WS_NEED); grid = -1; return; }
        int dev = 0, cus = 0, per_cu = 0;
        (void)hipGetDevice(&dev);
        (void)hipDeviceGetAttribute(&cus, hipDeviceAttributeMultiprocessorCount, dev);
        if (hipFuncSetAttribute((const void*)hymba_fwd, hipFuncAttributeMaxDynamicSharedMemorySize, LDS_BYTES) != hipSuccess) { fprintf(stderr, "kernel_launch: hipFuncSetAttribute failed\n"); grid = -1; return; }
        if (hipOccupancyMaxActiveBlocksPerMultiprocessor(&per_cu, (const void*)hymba_fwd, 512, LDS_BYTES) != hipSuccess || per_cu < 1) { fprintf(stderr, "kernel_launch: occupancy query gave %d\n", per_cu); per_cu = 1; }
        (void)hipGetLastError();
        grid = cus * 1;
        if (grid <= 0) grid = 256;
    }
    if (grid < 0) return;
    Params p{};
    for (int i = 0; i < 28; ++i) p.in[i] = (const float*)d_in[i];
    p.X = (float*)d_out; p.ws = (unsigned char*)d_ws; p.ph_lo = 0; p.ph_hi = NPHASE;
    if (hipMemsetAsync((unsigned char*)d_ws + OFF_BAR, 0, BAR_BYTES, stream) != hipSuccess) { fprintf(stderr, "kernel_launch: memset of the barrier words failed\n"); return; }
    void* args[] = {&p};
    hipError_t e = hipLaunchCooperativeKernel((const void*)hymba_fwd, dim3(grid), dim3(512), args, LDS_BYTES, stream);
    if (e != hipSuccess) fprintf(stderr, "kernel_launch: cooperative launch failed: %s (grid %d)\n", hipGetErrorString(e), grid);
}
```

```cpp
#include <hip/hip_runtime.h>
#include <hip/hip_cooperative_groups.h>
#include <cstdio>
#include <cstdint>
namespace cg = cooperative_groups;
__device__ __forceinline__ int ltid() { int t = threadIdx.x; asm volatile("" : "+v"(t)); return t; }
template <class T> __device__ __forceinline__ T* lptr(T* q) { int z = 0; asm volatile("" : "+s"(z)); return q + z; }
namespace pg8 {
#define PG8_LAS __attribute__((address_space(3)))
typedef unsigned short bf16_t;
typedef short bf16x8 __attribute__((ext_vector_type(8)));
typedef float f32x4 __attribute__((ext_vector_type(4)));
typedef unsigned u32x4 __attribute__((ext_vector_type(4)));
constexpr int BM = 256, BK = 64, HALF = 128, HTB = HALF * BK * 2  , STAGE_BYTES = 8 * HTB, NXCD = 8, WGM = 8;

__host__ __device__ __forceinline__ int lds_byte(int r, int c) { const int st = (r >> 4) * 2 + (c >> 5), rr = r & 15, cc = c & 31, ob = rr * 64 + cc * 2; return st * 1024 + (ob ^ (((ob >> 9) & 1) << 5)); }
__host__ __device__ __forceinline__ void stage_rc(int b, int& R, int& C) { const int st = b / 1024, sb = b % 1024, swz = sb ^ (((sb >> 9) & 1) << 5); R = (st >> 1) * 16 + swz / 64; C = (st & 1) * 32 + (swz % 64) / 2; }
__host__ __device__ __forceinline__ int perm32(int rho) { const int n = rho >> 4, i = rho & 15; return 8 * (i >> 2) + 4 * n + (i & 3); }

struct Unit { int pm, pn; };
struct Gemm { const bf16_t* A; const bf16_t* Bt; int M, N, K; };
struct StaticOrder {
    int nM, nN, nwg, G, c;
    __host__ __device__ void init(int M, int N, int G_, int c_) { nM = M / BM; nN = N / BM; nwg = nM * nN; G = G_; c = c_; }
    __host__ __device__ bool next(int i, Unit& u) const {
        const long L = (long)i * G + c; if (L >= nwg) return false;
        int wgid = (int)L; { const int q = nwg / NXCD, r = nwg % NXCD, xcd = wgid % NXCD, off = wgid / NXCD; wgid = (xcd < r ? xcd * (q + 1) : r * (q + 1) + (xcd - r) * q) + off; }
        const int nig = WGM * nN, gid = wgid / nig, fm = gid * WGM, gsz = (nM - fm) < WGM ? (nM - fm) : WGM;
        u.pm = fm + ((wgid % nig) % gsz); u.pn = (wgid % nig) / gsz; return true;
    }
    __device__ __forceinline__ void a_ready(const Unit&) const {}
    __device__ __forceinline__ void done(const Unit&) const {}
};
__device__ __forceinline__ unsigned cvt_pk_bf16(float lo, float hi) { unsigned r; asm("v_cvt_pk_bf16_f32 %0, %1, %2" : "=v"(r) : "v"(lo), "v"(hi)); return r; }
struct EpiSwiGLU {
    static constexpr bool PERM = true, AFTER_DRAIN = false;
    bf16_t* O;
    __device__ __forceinline__ void operator()(const f32x4 (&acc)[2][2][4][2], const Unit& u, int wr, int wc, int fr, int fq) const {
        const int row0 = u.pm * BM + wr * 64 + fr, col0 = u.pn * 128 + wc * 32 + 8 * fq;
#pragma unroll
        for (int ai = 0; ai < 2; ++ai)
#pragma unroll
            for (int m = 0; m < 4; ++m) {
                bf16_t* p = O + (size_t)(row0 + ai * HALF + m * 16) * 2816 + col0;
                float v[8];
#pragma unroll
                for (int n = 0; n < 2; ++n)
#pragma unroll
                    for (int j = 0; j < 4; ++j) { const float g = acc[ai][0][m][n][j], uu = acc[ai][1][m][n][j]; v[n * 4 + j] = g * uu * __builtin_amdgcn_rcpf(1.0f + __expf(-g)); }
                u32x4 pk; pk[0] = cvt_pk_bf16(v[0], v[1]); pk[1] = cvt_pk_bf16(v[2], v[3]); pk[2] = cvt_pk_bf16(v[4], v[5]); pk[3] = cvt_pk_bf16(v[6], v[7]);
                *(u32x4*)p = pk;
            }
    }
};
struct EpiResid {
    static constexpr bool PERM = false, AFTER_DRAIN = false;
    float* X; const float* gate; float coef; const float2* stats; const float* lng; const float* lnb;
    __device__ __forceinline__ void operator()(const f32x4 (&acc)[2][2][4][2], const Unit& u, int wr, int wc, int fr, int fq) const {
        const int bidx = u.pm < 256 ? (u.pm >> 4) : 16 + ((u.pm - 256) >> 3);
        const int row0 = u.pm * BM + wr * 64 + fr, col0 = u.pn * BM + wc * 32 + 4 * fq;
        const float* gp = gate + (size_t)bidx * 9216 + col0;
#pragma unroll
        for (int bj = 0; bj < 2; ++bj)
#pragma unroll
            for (int n = 0; n < 2; ++n) {
                const int co = bj * HALF + n * 16;
                const f32x4 gt = (*(const f32x4*)(gp + co) + 1.0f) * coef;
                f32x4 gg = {1.f, 1.f, 1.f, 1.f}, be = {0.f, 0.f, 0.f, 0.f};
                if (lng) { gg = *(const f32x4*)(lng + col0 + co); be = *(const f32x4*)(lnb + col0 + co); }
#pragma unroll
                for (int ai = 0; ai < 2; ++ai) {
                    f32x4 xv[4]; float2 st[4];
                    int zv = 0; asm volatile("" : "+v"(zv));
                    float* xb = X + (size_t)(row0 + ai * HALF) * 1024 + col0 + co + zv;
                    const float2* sb = stats + row0 + ai * HALF + zv;
#pragma unroll
                    for (int m = 0; m < 4; ++m) { xv[m] = *(const f32x4*)(xb + m * 16384); st[m] = sb[m * 16]; }
#pragma unroll
                    for (int m = 0; m < 4; ++m) {
                        const float mu = lng ? st[m].x : 0.f, rs = lng ? st[m].y : 1.f;
                        const f32x4 xl = (xv[m] - mu) * rs * gg + be;
                        *(f32x4*)(xb + m * 16384) = xl * 1.681792830507429f + gt * acc[ai][bj][m][n];
                    }
                }
            }
    }
};
struct EpiStore {
    static constexpr bool PERM = true, AFTER_DRAIN = false;
    bf16_t* O; size_t ldc;
    __device__ __forceinline__ void operator()(const f32x4 (&acc)[2][2][4][2], const Unit& u, int wr, int wc, int fr, int fq) const {
        const int row0 = u.pm * BM + wr * 64 + fr, col0 = u.pn * BM + wc * 32 + 8 * fq;
#pragma unroll
        for (int ai = 0; ai < 2; ++ai)
#pragma unroll
            for (int m = 0; m < 4; ++m) { bf16_t* p = O + (size_t)(row0 + ai * HALF + m * 16) * ldc + col0;
#pragma unroll
                for (int bj = 0; bj < 2; ++bj) { const f32x4 v0 = acc[ai][bj][m][0], v1 = acc[ai][bj][m][1];
                    u32x4 pk; pk[0] = cvt_pk_bf16(v0[0], v0[1]); pk[1] = cvt_pk_bf16(v0[2], v0[3]); pk[2] = cvt_pk_bf16(v1[0], v1[1]); pk[3] = cvt_pk_bf16(v1[2], v1[3]);
                    *(u32x4*)(p + bj * HALF) = pk; } }
    }
};

struct EpiAny {
    static constexpr bool AFTER_DRAIN = false;
    int mode; bool perm; bf16_t* O; size_t ldc; float* X; const float* gate; float coef; const float2* stats; const float* lng; const float* lnb;
    __device__ __forceinline__ void operator()(const f32x4 (&acc)[2][2][4][2], const Unit& u, int wr, int wc, int fr, int fq) const {
        if (mode == 0) { EpiSwiGLU e{O}; e(acc, u, wr, wc, fr, fq); }
        else if (mode == 1) { EpiResid e{X, gate, coef, stats, lng, lnb}; e(acc, u, wr, wc, fr, fq); }
        else { EpiStore e{O, ldc}; e(acc, u, wr, wc, fr, fq); }
    }
};
template <class Epi, class Sched, bool ALIGN_EPI = false, bool SP2 = false>
__device__ __forceinline__ void gemm_phase(PG8_LAS unsigned char* lds, const Gemm g, const Sched& S, const Epi& E) {
    const int tid = ltid(), wid = __builtin_amdgcn_readfirstlane(tid >> 6), lane = tid & 63, wr = wid >> 2, wc = wid & 3, fr = lane & 15, fq = lane >> 4;
    const int K = g.K, nt = K / BK;
    unsigned voffA[2], voffB[2];
#pragma unroll
    for (int i = 0; i < 2; ++i) { int R, C; stage_rc(tid * 16 + i * 8192, R, C); const int Rb = E.perm ? ((R & ~31) + perm32(R & 31)) : R;
        voffA[i] = (unsigned)(R * K + C) * 2u; voffB[i] = (unsigned)(Rb * K + C) * 2u; }
    const size_t kstep = (size_t)(BK * 2);
    const size_t hstep = (size_t)HALF * K * 2;
    const size_t tstep = 2 * hstep;
    const unsigned ldsw = (unsigned)wid * 1024u;
    const int aoff = lds_byte(wr * 64 + fr, fq * 8), boff = lds_byte(wc * 32 + fr, fq * 8);
#define PG8_SA(b, h) (((b) * 2 + (h)) * HTB)
#define PG8_SB(b, h) ((4 + (b) * 2 + (h)) * HTB)
#define PG8_STAGE(bufoff, gbase, voff) do { _Pragma("unroll") for (int _i = 0; _i < 2; ++_i) \
        __builtin_amdgcn_global_load_lds((const unsigned*)((const char*)(gbase) + (voff)[_i]), (PG8_LAS unsigned*)(lds + (bufoff) + ldsw + _i * 8192), 16, 0, 0); } while (0)
#define PG8_LDA(dst, b, h) do { _Pragma("unroll") for (int m = 0; m < 4; ++m) _Pragma("unroll") for (int k = 0; k < 2; ++k) dst[m][k] = *(const PG8_LAS bf16x8*)(lds + PG8_SA(b, h) + aoff + m * 2048 + k * 1024); } while (0)
#define PG8_LDB(dst, b, h) do { _Pragma("unroll") for (int n = 0; n < 2; ++n) _Pragma("unroll") for (int k = 0; k < 2; ++k) dst[n][k] = *(const PG8_LAS bf16x8*)(lds + PG8_SB(b, h) + boff + n * 2048 + k * 1024); } while (0)
#define PG8_MMA(ai, bj, At, Bt) do { __builtin_amdgcn_s_setprio(1); _Pragma("unroll") for (int m = 0; m < 4; ++m) _Pragma("unroll") for (int n = 0; n < 2; ++n) _Pragma("unroll") for (int k = 0; k < 2; ++k) \
        acc[ai][bj][m][n] = __builtin_amdgcn_mfma_f32_16x16x32_bf16(Bt[n][k], At[m][k], acc[ai][bj][m][n], 0, 0, 0); __builtin_amdgcn_s_setprio(0); } while (0)
#define PG8_WAIT_V(n) asm volatile("s_waitcnt vmcnt(" #n ")" ::: "memory")
#define PG8_WAIT_L(n) asm volatile("s_waitcnt lgkmcnt(" #n ")" ::: "memory")
#define PG8_BAR __builtin_amdgcn_s_barrier()
#define PG8_SCHED __builtin_amdgcn_sched_barrier(0)
    Unit cur, nxt; int ui = 0;
    if (!S.next(0, cur)) return;
    f32x4 acc[2][2][4][2];
#pragma unroll
    for (int a = 0; a < 2; ++a)
#pragma unroll
        for (int b = 0; b < 2; ++b)
#pragma unroll
            for (int m = 0; m < 4; ++m)
#pragma unroll
                for (int n = 0; n < 2; ++n) acc[a][b][m][n] = (f32x4){0.f, 0.f, 0.f, 0.f};
    bf16x8 At[4][2], B0[2][2], B1[2][2];
    const char* cA = (const char*)g.A + (size_t)cur.pm * tstep; const char* cB = (const char*)g.Bt + (size_t)cur.pn * tstep;
    S.a_ready(cur);
    if constexpr (SP2) {
        PG8_STAGE(PG8_SB(0, 0), cB, voffB); PG8_STAGE(PG8_SB(0, 1), cB + hstep, voffB); PG8_STAGE(PG8_SA(0, 0), cA, voffA); PG8_STAGE(PG8_SA(0, 1), cA + hstep, voffA);
        if (wr == 1) PG8_BAR;
        PG8_WAIT_V(2); PG8_BAR;
        PG8_STAGE(PG8_SB(1, 0), cB + kstep, voffB); PG8_STAGE(PG8_SA(1, 0), cA + kstep, voffA); PG8_STAGE(PG8_SB(1, 1), cB + hstep + kstep, voffB);
        PG8_WAIT_V(6); PG8_BAR;
    } else {
        PG8_STAGE(PG8_SB(0, 0), cB, voffB); PG8_STAGE(PG8_SA(0, 0), cA, voffA); PG8_STAGE(PG8_SB(0, 1), cB + hstep, voffB); PG8_STAGE(PG8_SA(0, 1), cA + hstep, voffA);
        if (wr == 1) PG8_BAR;
        PG8_WAIT_V(4); PG8_BAR;
        PG8_STAGE(PG8_SB(1, 0), cB + kstep, voffB); PG8_STAGE(PG8_SA(1, 0), cA + kstep, voffA); PG8_STAGE(PG8_SB(1, 1), cB + hstep + kstep, voffB);
        PG8_WAIT_V(6); PG8_BAR;
    }
    for (;;) {
        const bool has_next = S.next(ui + 1, nxt);
        const char* nA = has_next ? (const char*)g.A + (size_t)nxt.pm * tstep : cA; const char* nB = has_next ? (const char*)g.Bt + (size_t)nxt.pn * tstep : cB;
        for (int t = 0; t < nt; t += 2) {
            const bool last = (t == nt - 2);
            const char* a1 = cA + (size_t)(t + 1) * kstep;
            const char* a2 = last ? nA : cA + (size_t)(t + 2) * kstep; const char* b2 = last ? nB : cB + (size_t)(t + 2) * kstep;
            const char* a3 = a2 + kstep; const char* b3 = b2 + kstep;
            if (last && has_next) S.a_ready(nxt);
            if constexpr (SP2) {
            PG8_LDB(B0, 0, 0); PG8_LDB(B1, 0, 1); PG8_SCHED; PG8_LDA(At, 0, 0); PG8_STAGE(PG8_SA(1, 1), a1 + hstep, voffA);
            PG8_WAIT_V(8); PG8_WAIT_L(0); PG8_BAR; PG8_MMA(0, 0, At, B0); PG8_MMA(0, 1, At, B1); PG8_BAR; PG8_SCHED;
            PG8_LDA(At, 0, 1); PG8_STAGE(PG8_SB(0, 0), b2, voffB); PG8_STAGE(PG8_SB(0, 1), b2 + hstep, voffB); PG8_STAGE(PG8_SA(0, 0), a2, voffA);
            PG8_WAIT_V(8); PG8_WAIT_L(0); PG8_BAR; PG8_MMA(1, 0, At, B0); PG8_MMA(1, 1, At, B1); PG8_BAR; PG8_SCHED;
            PG8_LDB(B0, 1, 0); PG8_LDB(B1, 1, 1); PG8_SCHED; PG8_LDA(At, 1, 0); PG8_STAGE(PG8_SA(0, 1), a2 + hstep, voffA);
            PG8_WAIT_V(8); PG8_WAIT_L(0); PG8_BAR; PG8_MMA(0, 0, At, B0); PG8_MMA(0, 1, At, B1); PG8_BAR; PG8_SCHED;
            PG8_LDA(At, 1, 1); PG8_STAGE(PG8_SB(1, 0), b3, voffB); PG8_STAGE(PG8_SB(1, 1), b3 + hstep, voffB); PG8_STAGE(PG8_SA(1, 0), a3, voffA);
            PG8_WAIT_V(8); PG8_WAIT_L(0); PG8_BAR; PG8_MMA(1, 0, At, B0); PG8_MMA(1, 1, At, B1); PG8_BAR; PG8_SCHED;
            } else {
            PG8_LDB(B0, 0, 0); PG8_SCHED; PG8_LDA(At, 0, 0); PG8_STAGE(PG8_SA(1, 1), a1 + hstep, voffA);
            PG8_WAIT_L(8); PG8_BAR; PG8_WAIT_L(0); PG8_MMA(0, 0, At, B0); PG8_BAR; PG8_SCHED;
            PG8_LDB(B1, 0, 1); PG8_STAGE(PG8_SB(0, 0), b2, voffB);
            PG8_BAR; PG8_WAIT_L(0); PG8_MMA(0, 1, At, B1); PG8_BAR;
            PG8_LDA(At, 0, 1); PG8_STAGE(PG8_SA(0, 0), a2, voffA);
            PG8_BAR; PG8_WAIT_L(0); PG8_MMA(1, 0, At, B0); PG8_BAR; PG8_SCHED;
            PG8_STAGE(PG8_SB(0, 1), b2 + hstep, voffB);
            PG8_WAIT_V(6); PG8_BAR; PG8_MMA(1, 1, At, B1); PG8_BAR;
            PG8_LDB(B0, 1, 0); PG8_SCHED; PG8_LDA(At, 1, 0); PG8_STAGE(PG8_SA(0, 1), a2 + hstep, voffA);
            PG8_WAIT_L(8); PG8_BAR; PG8_WAIT_L(0); PG8_MMA(0, 0, At, B0); PG8_BAR; PG8_SCHED;
            PG8_LDB(B1, 1, 1); PG8_STAGE(PG8_SB(1, 0), b3, voffB);
            PG8_BAR; PG8_WAIT_L(0); PG8_MMA(0, 1, At, B1); PG8_BAR;
            PG8_LDA(At, 1, 1); PG8_STAGE(PG8_SA(1, 0), a3, voffA);
            PG8_BAR; PG8_WAIT_L(0); PG8_MMA(1, 0, At, B0); PG8_BAR; PG8_SCHED;
            PG8_STAGE(PG8_SB(1, 1), b3 + hstep, voffB);
            PG8_WAIT_V(6); PG8_BAR; PG8_MMA(1, 1, At, B1); PG8_BAR;
            }
        }
        if constexpr (ALIGN_EPI) { if (wr == 0) PG8_BAR; }
        if constexpr (!Epi::AFTER_DRAIN) { E(acc, cur, wr, wc, fr, fq); S.done(cur); }
        if (!has_next) break;
#pragma unroll
        for (int a = 0; a < 2; ++a)
#pragma unroll
            for (int b = 0; b < 2; ++b)
#pragma unroll
                for (int m = 0; m < 4; ++m)
#pragma unroll
                    for (int n = 0; n < 2; ++n) acc[a][b][m][n] = (f32x4){0.f, 0.f, 0.f, 0.f};
        cur = nxt; cA = nA; cB = nB; ++ui;
        if constexpr (ALIGN_EPI) { if (wr == 1) PG8_BAR; }
    }
    PG8_WAIT_V(0);
    if constexpr (!ALIGN_EPI) { if (wr == 0) PG8_BAR; }
    PG8_BAR;
    if constexpr (Epi::AFTER_DRAIN) { E.fused(acc, cur, wr, wc, fr, fq, lds, wid, lane); S.done(cur); }
#undef PG8_SA
#undef PG8_SB
#undef PG8_STAGE
#undef PG8_LDA
#undef PG8_LDB
#undef PG8_MMA
#undef PG8_WAIT_V
#undef PG8_WAIT_L
#undef PG8_BAR
#undef PG8_SCHED
}
}

typedef unsigned short bf16_t;
typedef short bf16x8 __attribute__((ext_vector_type(8)));
typedef float f32x4 __attribute__((ext_vector_type(4)));
typedef float f32x16 __attribute__((ext_vector_type(16)));
typedef unsigned u32x4 __attribute__((ext_vector_type(4)));
typedef unsigned u32x2 __attribute__((ext_vector_type(2)));

constexpr int MTOT = 98304, NLAYER = 4;
constexpr size_t WL_ELEMS = 20971520;
constexpr size_t WO_WI1 = 0, WO_WO1 = 5767168, WO_WI2 = 8650752, WO_WO2 = 14417920, WO_WINA = 17301504, WO_WINB = 18087936, WO_WOUT = 19922944;
constexpr size_t OFF_W = 0;
constexpr size_t OFF_MOD = 167772160;
constexpr size_t OFF_ROPE = OFF_MOD + 4718592;
constexpr size_t OFF_H3 = OFF_ROPE + 262144;
constexpr size_t OFF_KF = OFF_H3 + 6291456;
constexpr int KS4 = 4104, KS2 = 2056;
constexpr size_t KF_LAYER = (size_t)512 * (KS4 + KS2);
constexpr size_t OFF_H = OFF_KF + 4 * KF_LAYER * 8;
constexpr size_t OFF_ACT = OFF_H + (size_t)MTOT * 1024 * 2;
constexpr size_t OFF_ZA = OFF_ACT;
constexpr size_t OFF_ZT = OFF_ACT + (size_t)MTOT * 768 * 2;
constexpr size_t OFF_STATS = OFF_ACT + (size_t)MTOT * 2816 * 2;
constexpr size_t OFF_BAR = OFF_STATS + (size_t)MTOT * 8;
constexpr size_t BAR_BYTES = 16384;
constexpr size_t WS_NEED = OFF_BAR + BAR_BYTES;
static_assert(OFF_ZT + (size_t)1792 * MTOT * 2 <= OFF_STATS, "mixer overlay fits");
constexpr int LDS_BYTES = 137216;
constexpr int NPHASE = 2 + 11 * NLAYER;
#ifndef GEMM_ALIGN
#define GEMM_ALIGN true
#endif
#ifndef GEMM_SP2
#define GEMM_SP2 true
#endif
#ifndef EN_GEMM
#define EN_GEMM 1
#endif
#ifndef EN_LN
#define EN_LN 1
#endif
#ifndef EN_ATT
#define EN_ATT 1
#endif
#ifndef EN_HY
#define EN_HY 1
#endif
#ifndef EN_RMS
#define EN_RMS 1
#endif
#ifndef EN_P0
#define EN_P0 1
#endif
#ifndef EN_P1
#define EN_P1 1
#endif

struct Params { const float* in[28]; float* X; unsigned char* ws; int ph_lo, ph_hi; };
#define PIN (p.in + zl)
__device__ __forceinline__ int launder0() { int z = 0; asm volatile("" : "+s"(z)); return z; }

__device__ __forceinline__ float bf_lo(unsigned u) { return __uint_as_float(u << 16); }
__device__ __forceinline__ float bf_hi(unsigned u) { return __uint_as_float(u & 0xffff0000u); }
__device__ __forceinline__ float bf2f(bf16_t b) { return __uint_as_float(((unsigned)b) << 16); }
__device__ __forceinline__ unsigned pk2(float lo, float hi) { return pg8::cvt_pk_bf16(lo, hi); }
__device__ __forceinline__ float sin_rev(float r) { return __builtin_amdgcn_sinf(r); }
__device__ __forceinline__ float cos_rev(float r) { return __builtin_amdgcn_cosf(r); }
__device__ __forceinline__ float sin_rad(float x) { float r = x * 0.15915494309189535f; r -= rintf(r); return __builtin_amdgcn_sinf(r); }
__device__ __forceinline__ float cos_rad(float x) { float r = x * 0.15915494309189535f; r -= rintf(r); return __builtin_amdgcn_cosf(r); }
__device__ __forceinline__ float wave_sum(float v) {
#pragma unroll
    for (int o = 1; o < 64; o <<= 1) v += __shfl_xor(v, o);
    return v;
}
__device__ __forceinline__ int row_bidx(int row) { return row < 65536 ? (row >> 12) : 16 + ((row - 65536) >> 11); }

__device__ __forceinline__ void cvt_tile(const float* __restrict__ src, int ldN, int k0, int c0, bf16_t* __restrict__ dst, int ldK, int n0, bool zero, float* tile) {
    const int tid = ltid();
    {
        const int r = tid >> 4, c4 = (tid & 15) * 4;
#pragma unroll
        for (int ps = 0; ps < 2; ++ps) {
            const int k = r + 32 * ps;
            f32x4 v = {0.f, 0.f, 0.f, 0.f};
            if (!zero) v = *(const f32x4*)(src + (size_t)(k0 + k) * ldN + c0 + c4);
            tile[k * 65 + c4 + 0] = v[0]; tile[k * 65 + c4 + 1] = v[1]; tile[k * 65 + c4 + 2] = v[2]; tile[k * 65 + c4 + 3] = v[3];
        }
    }
    __syncthreads();
    {
        const int n = tid >> 3, kq = tid & 7;
        float f[8];
#pragma unroll
        for (int j = 0; j < 8; ++j) f[j] = tile[(kq * 8 + j) * 65 + n];
        u32x4 pk; pk[0] = pk2(f[0], f[1]); pk[1] = pk2(f[2], f[3]); pk[2] = pk2(f[4], f[5]); pk[3] = pk2(f[6], f[7]);
        *(u32x4*)(dst + (size_t)(n0 + n) * ldK + k0 + kq * 8) = pk;
    }
    __syncthreads();
}

__device__ __forceinline__ void phase0a(const Params& p, unsigned char* smem) {
    const int zl = launder0(); unsigned char* const wsp = lptr(p.ws); float* const xp = lptr(p.X); (void)xp;
    const int tid = ltid();
    float* tile = (float*)smem;
    for (int t = blockIdx.x; t < 20480; t += gridDim.x) {
        const int l = t / 5120, r = t % 5120;
        bf16_t* wl = (bf16_t*)(wsp + OFF_W) + (size_t)l * WL_ELEMS;
        const float* src; int ldN, k0, c0, ldK, n0; bf16_t* dst; bool zero = false;
        if (r < 2816) {
            const int which = r / 1408, rr = r % 1408, nt = rr / 16, kt = rr % 16;
            src = PIN[which ? 8 : 6] + (size_t)l * 1024 * 5632; ldN = 5632; k0 = kt * 64; n0 = nt * 64;
            const int tt = n0 >> 8, within = n0 & 255;
            c0 = within < 128 ? 128 * tt + within : 2816 + 128 * tt + (within - 128);
            dst = wl + (which ? WO_WI2 : WO_WI1); ldK = 1024;
        } else if (r < 4224) {
            const int q = r - 2816, which = q / 704, rr = q % 704, nt = rr / 44, kt = rr % 44;
            src = PIN[which ? 9 : 7] + (size_t)l * 2816 * 1024; ldN = 1024; k0 = kt * 64; n0 = nt * 64; c0 = n0;
            dst = wl + (which ? WO_WO2 : WO_WO1); ldK = 2816;
        } else if (r < 4416) {
            const int q = r - 4224, nt = q / 16, kt = q % 16;
            src = PIN[12] + (size_t)l * 1024 * 2304; ldN = 2304; k0 = kt * 64; n0 = nt * 64; c0 = n0;
            dst = wl + WO_WINA; ldK = 1024;
        } else if (r < 4864) {
            const int q = r - 4416, nt = q / 16, kt = q % 16;
            src = PIN[12] + (size_t)l * 1024 * 2304; ldN = 2304; k0 = kt * 64; n0 = nt * 64;
            if (n0 < 1536) c0 = 768 + n0; else if (n0 < 1664) c0 = 640 + (n0 - 1536); else { c0 = 0; zero = true; }
            dst = wl + WO_WINB; ldK = 1024;
        } else {
            const int q = r - 4864, nt = q / 16, kt = q % 16;
            src = PIN[13] + (size_t)l * 1024 * 1024; ldN = 1024; k0 = kt * 64; n0 = nt * 64; c0 = n0;
            dst = wl + WO_WOUT; ldK = 1024;
        }
        cvt_tile(src, ldN, k0, c0, dst, ldK, n0, zero, tile);
    }
    {
        float* sc = (float*)smem;
        float* MOD = (float*)(wsp + OFF_MOD);
        for (int u = blockIdx.x; u < 288; u += gridDim.x) {
            const int l = u / 72, cch = u % 72;
            for (int idx = tid; idx < 32768; idx += 512) {
                const int b = idx >> 10, k = idx & 1023;
                const float c = b < 16 ? PIN[2][b * 1024 + k] : PIN[3][(b - 16) * 1024 + k];
                sc[k * 32 + b] = c / (1.0f + __expf(-c));
            }
            __syncthreads();
            const int cl = tid & 127, ks = tid >> 7, col = cch * 128 + cl;
            float acc[32];
#pragma unroll
            for (int b = 0; b < 32; ++b) acc[b] = 0.f;
            const float* wp = PIN[4] + ((size_t)l * 1024 + ks * 256) * 9216 + col;
            for (int k = 0; k < 256; ++k) {
                const float w = wp[(size_t)k * 9216];
                const f32x4* sp = (const f32x4*)(sc + (ks * 256 + k) * 32);
#pragma unroll
                for (int b4 = 0; b4 < 8; ++b4) { const f32x4 s = sp[b4]; acc[b4 * 4 + 0] += s[0] * w; acc[b4 * 4 + 1] += s[1] * w; acc[b4 * 4 + 2] += s[2] * w; acc[b4 * 4 + 3] += s[3] * w; }
            }
            __syncthreads();
            float* part = (float*)smem;
#pragma unroll
            for (int b = 0; b < 32; ++b) part[(ks * 32 + b) * 128 + cl] = acc[b];
            __syncthreads();
            for (int idx = tid; idx < 4096; idx += 512) {
                const int b = idx >> 7, c2 = idx & 127, cc = cch * 128 + c2;
                const float s = part[(0 * 32 + b) * 128 + c2] + part[(1 * 32 + b) * 128 + c2] + part[(2 * 32 + b) * 128 + c2] + part[(3 * 32 + b) * 128 + c2];
                MOD[((size_t)l * 32 + b) * 9216 + cc] = s + PIN[5][l * 9216 + cc];
            }
            __syncthreads();
        }
    }
    {
        float* zb = (float*)smem; float* ha = zb + 8 * 40; float* hb = ha + 8 * 64;
        float* H3 = (float*)(wsp + OFF_H3);
        for (int u = blockIdx.x; u < 384; u += gridDim.x) {
            const int l = u / 96, v = u % 96;
            const int Lsel = v >= 64, chunk = Lsel ? v - 64 : v, L = Lsel ? 2048 : 4096;
            const int lr = tid >> 6, j = tid & 63;
            const float fr = PIN[25][l * 64 + j];
            for (int it = 0; it < 8; ++it) {
                const int pos = chunk * 64 + it * 8 + lr;
                if (j < 33) {
                    const float tt = (float)pos / (float)(L - 1), w = (6.2831855f * (float)pos) / (float)L;
                    float val;
                    if (j == 0) val = tt;
                    else if (j <= 16) { const float fb = 1e-4f + (float)(j - 1) * 0.99999333f; val = cos_rad(fb * w); }
                    else { const float fb = 1e-4f + (float)(j - 17) * 0.99999333f; val = -sin_rad(fb * w); }
                    zb[lr * 40 + j] = val;
                }
                __syncthreads();
                float a = PIN[19][l * 64 + j];
                for (int i = 0; i < 33; ++i) a += zb[lr * 40 + i] * PIN[18][((size_t)l * 33 + i) * 64 + j];
                ha[lr * 64 + j] = sin_rad(fr * a);
                __syncthreads();
                a = PIN[21][l * 64 + j];
                for (int i = 0; i < 64; ++i) a += ha[lr * 64 + i] * PIN[20][((size_t)l * 64 + i) * 64 + j];
                hb[lr * 64 + j] = sin_rad(fr * a);
                __syncthreads();
                a = PIN[23][l * 64 + j];
                for (int i = 0; i < 64; ++i) a += hb[lr * 64 + i] * PIN[22][((size_t)l * 64 + i) * 64 + j];
                H3[((size_t)l * 6144 + (Lsel ? 4096 : 0) + pos) * 64 + j] = sin_rad(fr * a);
                __syncthreads();
            }
        }
    }
    {
        const double INV[8] = {1.0, 0.19392274474868576, 0.03760603093086393, 0.007292664737217109, 0.001414213562373095, 0.0002742481756762073, 5.318295896944988e-05, 1.031338537721246e-05};
        float2* rope = (float2*)(wsp + OFF_ROPE);
        for (int idx = blockIdx.x * 512 + tid; idx < 32768; idx += gridDim.x * 512) {
            const int pos = idx >> 3, i = idx & 7;
            double inv = INV[0];
#pragma unroll
            for (int q = 1; q < 8; ++q) inv = (i == q) ? INV[q] : inv;
            double r = (double)pos * inv * 0.15915494309189535; r -= rint(r);
            const float rf = (float)r;
            rope[idx] = make_float2(cos_rev(rf), sin_rev(rf));
        }
    }
}

__device__ __forceinline__ int PIX(int i) { return i + (i >> 5); }
constexpr int FFT_LDS_BYTES = (8192 + 256) * 8;
__device__ __forceinline__ float2 cmul(float2 a, float2 b) { return make_float2(a.x * b.x - a.y * b.y, a.x * b.y + a.y * b.x); }
__device__ __forceinline__ float2 cmulc(float2 a, float2 b) { return make_float2(a.x * b.x + a.y * b.y, a.y * b.x - a.x * b.y); }
#define ROOT16X(k) ((k) == 0 ? 1.0f : (k) == 1 ? 0.92387953251f : (k) == 2 ? 0.70710678119f : (k) == 3 ? 0.38268343237f : (k) == 4 ? 0.0f : (k) == 5 ? -0.38268343237f : (k) == 6 ? -0.70710678119f : -0.92387953251f)
#define ROOT16Y(k) ((k) == 0 ? 0.0f : (k) == 1 ? -0.38268343237f : (k) == 2 ? -0.70710678119f : (k) == 3 ? -0.92387953251f : (k) == 4 ? -1.0f : (k) == 5 ? -0.92387953251f : (k) == 6 ? -0.70710678119f : -0.38268343237f)
constexpr int FFT_BUF_STRIDE = 8192 + 256;
template <int LOGN, int S, int R, bool INV, int NB>
__device__ __forceinline__ void fft_pass(float2* buf, int tid) {
    constexpr int RR = 1 << R, N = 1 << LOGN, lgD = LOGN - S - R, D = 1 << lgD, ngroups = N >> R;
    static_assert(D >= 32 || D == 16 || D == 2 || D == 1, "padded-index shortcut");
    for (int gidx = tid; gidx < ngroups; gidx += 512) {
        const int lo = gidx & (D - 1), hi = gidx >> lgD, base = (hi << (LOGN - S)) + lo, pb = PIX(base);
        const float fr = (float)lo * (1.0f / (float)(D << R));
        float2 wq[R];
        wq[0] = make_float2(cos_rev(fr), -sin_rev(fr));
#pragma unroll
        for (int q = 1; q < R; ++q) wq[q] = cmul(wq[q - 1], wq[q - 1]);
        float2 tw[RR];
#pragma unroll
        for (int q = 0; q < R; ++q) {
            const int h = 1 << (R - 1 - q);
#pragma unroll
            for (int k = 0; k < h; ++k) { const int ri = k << (4 - R + q); tw[RR - 2 * h + k] = cmul(wq[q], make_float2(ROOT16X(ri), ROOT16Y(ri))); }
        }
#pragma unroll
        for (int nb = 0; nb < NB; ++nb) {
            float2* bb = buf + nb * FFT_BUF_STRIDE;
            float2 v[RR];
#pragma unroll
            for (int m = 0; m < RR; ++m) v[m] = bb[pb + m * D + ((m * D) >> 5)];
#pragma unroll
            for (int qq = 0; qq < R; ++qq) {
                const int q = INV ? (R - 1 - qq) : qq;
                const int h = 1 << (R - 1 - q);
#pragma unroll
                for (int k = 0; k < h; ++k) {
                    const float2 t_w = tw[RR - 2 * h + k];
#pragma unroll
                    for (int blk = 0; blk < RR; blk += 2 * h) {
                        const int m0 = blk + k, m1 = m0 + h;
                        const float2 a = v[m0], b = v[m1];
                        if (!INV) { v[m0] = make_float2(a.x + b.x, a.y + b.y); v[m1] = cmul(make_float2(a.x - b.x, a.y - b.y), t_w); }
                        else { const float2 t = cmulc(b, t_w); v[m0] = make_float2(a.x + t.x, a.y + t.y); v[m1] = make_float2(a.x - t.x, a.y - t.y); }
                    }
                }
            }
#pragma unroll
            for (int m = 0; m < RR; ++m) bb[pb + m * D + ((m * D) >> 5)] = v[m];
        }
    }
    __syncthreads();
}
template <int LOGN, int NB> __device__ __forceinline__ void fft_fwd(float2* buf, int tid) {
    fft_pass<LOGN, 0, 4, false, NB>(buf, tid); fft_pass<LOGN, 4, 4, false, NB>(buf, tid); fft_pass<LOGN, 8, 4, false, NB>(buf, tid);
    if constexpr (LOGN == 13) fft_pass<LOGN, 12, 1, false, NB>(buf, tid);
}
template <int LOGN, int NB> __device__ __forceinline__ void fft_inv(float2* buf, int tid) {
    if constexpr (LOGN == 13) fft_pass<LOGN, 12, 1, true, NB>(buf, tid);
    fft_pass<LOGN, 8, 4, true, NB>(buf, tid); fft_pass<LOGN, 4, 4, true, NB>(buf, tid); fft_pass<LOGN, 0, 4, true, NB>(buf, tid);
}

template <int LOGN>
__device__ __forceinline__ void filt_unit(const Params& p, int l, int cp, unsigned char* smem, int zl, unsigned char* wsp) {
    const int tid = ltid();
    float2* buf = (float2*)smem; float* w4s = (float*)(smem + 69632);
    const float* H3 = (const float*)(wsp + OFF_H3);
    float2* KF = (float2*)(wsp + OFF_KF);
    {
        constexpr int Lsel = (LOGN == 12), L = 1 << (LOGN - 1), logN = LOGN, N = 2 * L;
        if (tid < 256) { const int i = tid >> 2, q = tid & 3; w4s[tid] = PIN[24][((size_t)l * 64 + i) * 1024 + (q >> 1) * 512 + 2 * cp + (q & 1)]; }
        const float d00 = fabsf(PIN[26][(l * 2 + 0) * 512 + 2 * cp]), d01 = fabsf(PIN[26][(l * 2 + 0) * 512 + 2 * cp + 1]);
        const float d10 = fabsf(PIN[26][(l * 2 + 1) * 512 + 2 * cp]), d11 = fabsf(PIN[26][(l * 2 + 1) * 512 + 2 * cp + 1]);
        __syncthreads();
#pragma nounroll
        for (int pos = tid; pos < L; pos += 512) {
            const f32x4* hrow = (const f32x4*)(H3 + ((size_t)l * 6144 + (Lsel ? 4096 : 0) + pos) * 64);
            float a0 = 0.f, a1 = 0.f, a2 = 0.f, a3 = 0.f;
#pragma unroll
            for (int i4 = 0; i4 < 16; ++i4) {
                const f32x4 h = hrow[i4];
#pragma unroll
                for (int e = 0; e < 4; ++e) { const f32x4 wv = *(const f32x4*)(w4s + (i4 * 4 + e) * 4); a0 += h[e] * wv[0]; a1 += h[e] * wv[1]; a2 += h[e] * wv[2]; a3 += h[e] * wv[3]; }
            }
            const float tt = (float)pos / (float)(L - 1);
            const float hf1 = a0 * __expf(-tt * d00), hf2 = a1 * __expf(-tt * d01), hb1 = a2 * __expf(-tt * d10), hb2 = a3 * __expf(-tt * d11);
            if (pos == 0) { buf[0] = make_float2(hf1 + hb1, hf2 + hb2); buf[PIX(L)] = make_float2(0.f, 0.f); }
            else { buf[PIX(pos)] = make_float2(hf1, hf2); buf[PIX(N - pos)] = make_float2(hb1, hb2); }
        }
        __syncthreads();
        fft_fwd<LOGN, 1>(buf, tid);
        const float sc = 0.25f / (float)N;
        float2* K1 = KF + (size_t)l * KF_LAYER + (Lsel ? (size_t)512 * KS4 + (size_t)(2 * cp) * KS2 : (size_t)(2 * cp) * KS4);
        float2* K2 = K1 + (Lsel ? KS2 : KS4);
#pragma nounroll
        for (int k = tid; k <= L; k += 512) {
            const int pa = (int)(__brev((unsigned)k) >> (32 - logN)), pb = (int)(__brev((unsigned)((N - k) & (N - 1))) >> (32 - logN));
            const float2 a = buf[PIX(pa)], b = buf[PIX(pb)];
            K1[k] = make_float2((a.x + b.x) * sc, (a.y - b.y) * sc);
            K2[k] = make_float2((a.y + b.y) * sc, -(a.x - b.x) * sc);
        }
        __syncthreads();
    }
}

__device__ __forceinline__ void phase0b(const Params& p, unsigned char* smem) {
    const int zl = launder0(); unsigned char* const wsp = lptr(p.ws); float* const xp = lptr(p.X); (void)xp;
    const int tid = ltid(), lane = tid & 63, w = tid >> 6;
    float2* buf = (float2*)smem; float* w4s = (float*)(smem + 69632);
    const float* H3 = (const float*)(wsp + OFF_H3);
    float2* KF = (float2*)(wsp + OFF_KF);
    for (int v = blockIdx.x; v < 2048; v += gridDim.x) {
        const int l = v >> 9, ww = v & 511, cp = ww & 255;
        if (ww >> 8) filt_unit<12>(p, l, cp, smem, zl, wsp); else filt_unit<13>(p, l, cp, smem, zl, wsp);
    }
    {
        const float* MOD = (const float*)(wsp + OFF_MOD);
        bf16_t* H = (bf16_t*)(wsp + OFF_H);
        for (int rp = blockIdx.x * 8 + w; rp < MTOT / 2; rp += gridDim.x * 8) {
            const int row = rp * 2;
            const float* src = row < 65536 ? PIN[0] + (size_t)row * 1024 : PIN[1] + (size_t)(row - 65536) * 1024;
            const float* md = MOD + (size_t)row_bidx(row) * 9216;
            f32x4 v[2][4], sh[4], scl[4];
#pragma unroll
            for (int i = 0; i < 4; ++i) { const int col = i * 256 + lane * 4; v[0][i] = *(const f32x4*)(src + col); v[1][i] = *(const f32x4*)(src + 1024 + col); sh[i] = *(const f32x4*)(md + col); scl[i] = *(const f32x4*)(md + 1024 + col); }
#pragma unroll
            for (int r2 = 0; r2 < 2; ++r2)
#pragma unroll
                for (int i = 0; i < 4; ++i) {
                    const int col = i * 256 + lane * 4;
                    *(f32x4*)(xp + (size_t)(row + r2) * 1024 + col) = v[r2][i];
                    const f32x4 h = v[r2][i] * (scl[i] + 1.0f) + sh[i];
                    u32x2 pk; pk[0] = pk2(h[0], h[1]); pk[1] = pk2(h[2], h[3]);
                    *(u32x2*)(H + (size_t)(row + r2) * 1024 + col) = pk;
                }
        }
    }
}

__device__ __forceinline__ void lnmod_phase(unsigned char* wsp, float* xp, const float* __restrict__ g, const float* __restrict__ bb, const float* __restrict__ modbase, bool write_x) {
    const int tid = ltid(), lane = tid & 63, w = tid >> 6;
    bf16_t* H = (bf16_t*)(wsp + OFF_H);
    float2* stats = (float2*)(wsp + OFF_STATS);
    constexpr int NR = 4;
    for (int rp = blockIdx.x * 8 + w; rp < MTOT / NR; rp += gridDim.x * 8) {
        const int row = rp * NR;
        float* xr = xp + (size_t)row * 1024;
        f32x4 v[NR][4];
#pragma unroll
        for (int r2 = 0; r2 < NR; ++r2)
#pragma unroll
            for (int i = 0; i < 4; ++i) v[r2][i] = *(const f32x4*)(xr + r2 * 1024 + i * 256 + lane * 4);
        float mean[NR], rstd[NR];
#pragma unroll
        for (int r2 = 0; r2 < NR; ++r2) {
            float s = 0.f;
#pragma unroll
            for (int i = 0; i < 4; ++i) s += v[r2][i][0] + v[r2][i][1] + v[r2][i][2] + v[r2][i][3];
            mean[r2] = s;
        }
#pragma unroll
        for (int o = 1; o < 64; o <<= 1)
#pragma unroll
            for (int r2 = 0; r2 < NR; ++r2) mean[r2] += __shfl_xor(mean[r2], o);
#pragma unroll
        for (int r2 = 0; r2 < NR; ++r2) {
            mean[r2] *= (1.0f / 1024.0f);
            float q = 0.f;
#pragma unroll
            for (int i = 0; i < 4; ++i) { const f32x4 d = v[r2][i] - mean[r2]; q += d[0] * d[0] + d[1] * d[1] + d[2] * d[2] + d[3] * d[3]; }
            rstd[r2] = q;
        }
#pragma unroll
        for (int o = 1; o < 64; o <<= 1)
#pragma unroll
            for (int r2 = 0; r2 < NR; ++r2) rstd[r2] += __shfl_xor(rstd[r2], o);
#pragma unroll
        for (int r2 = 0; r2 < NR; ++r2) {
            rstd[r2] = rsqrtf(rstd[r2] * (1.0f / 1024.0f) + 1e-5f);
            if (lane == 0) stats[row + r2] = make_float2(mean[r2], rstd[r2]);
        }
        const float* md = modbase ? modbase + (size_t)row_bidx(row) * 9216 : nullptr;
#pragma unroll
        for (int i = 0; i < 4; ++i) {
            const int col = i * 256 + lane * 4;
            const f32x4 gg = *(const f32x4*)(g + col), be = *(const f32x4*)(bb + col);
            f32x4 sh = {0.f, 0.f, 0.f, 0.f}, scl = {0.f, 0.f, 0.f, 0.f};
            if (md) { sh = *(const f32x4*)(md + col); scl = *(const f32x4*)(md + 1024 + col); }
#pragma unroll
            for (int r2 = 0; r2 < NR; ++r2) {
                const f32x4 xn = (v[r2][i] - mean[r2]) * rstd[r2] * gg + be;
                if (write_x) *(f32x4*)(xr + r2 * 1024 + col) = xn;
                if (md) {
                    const f32x4 h = xn * (scl + 1.0f) + sh;
                    u32x2 pk; pk[0] = pk2(h[0], h[1]); pk[1] = pk2(h[2], h[3]);
                    *(u32x2*)(H + (size_t)(row + r2) * 1024 + col) = pk;
                }
            }
        }
    }
}

__device__ __forceinline__ u32x4 rope_apply(u32x4 mine, u32x4 other, const f32x4 (&cs)[4], int second) {
    u32x4 out;
#pragma unroll
    for (int q = 0; q < 4; ++q) {
        const float m0 = bf_lo(mine[q]), m1 = bf_hi(mine[q]), o0 = bf_lo(other[q]), o1 = bf_hi(other[q]);
        const float r0 = second ? m0 * cs[q][0] + o0 * cs[q][1] : m0 * cs[q][0] - o0 * cs[q][1];
        const float r1 = second ? m1 * cs[q][2] + o1 * cs[q][3] : m1 * cs[q][2] - o1 * cs[q][3];
        out[q] = pk2(r0, r1);
    }
    return out;
}

__device__ __forceinline__ void attn_unit(const Params& p, int l, int ua, unsigned char* smem) {
    const int zl = launder0(); unsigned char* const wsp = lptr(p.ws); float* const xp = lptr(p.X); (void)xp;
    const int tid = ltid(), lane = tid & 63, w = tid >> 6;
    const int qb = ua >> 1, g = ua & 1;
    int blk, nb;
    if (qb < 512) { blk = qb & 31; nb = 32; } else { blk = (qb - 512) & 15; nb = 16; }
    const int row0 = qb * 128, pos0 = blk * 128;
    const bool hasPrev = blk > 0, hasNext = blk < nb - 1;
    const bf16_t* ZA = (const bf16_t*)(wsp + OFF_ZA);
    const bf16_t* ZT = (const bf16_t*)(wsp + OFF_ZT);
    bf16_t* A2 = (bf16_t*)(wsp + OFF_H);
    const float2* rope = (const float2*)(wsp + OFF_ROPE);
    unsigned char* Ks = smem;
    unsigned char* Vs = smem + 55296;
    {
        u32x4 kv[5], vv[6], k0 = {0u, 0u, 0u, 0u}, k1 = {0u, 0u, 0u, 0u};
        f32x4 cs[4];
#pragma unroll
        for (int q = 0; q < 4; ++q) cs[q] = (f32x4){1.f, 0.f, 1.f, 0.f};
#pragma unroll
        for (int i = 0; i < 5; ++i) {
            const int idx = tid + 512 * i, kb = idx / 6, part = 2 + idx % 6, b3 = kb >> 7;
            const bool valid = (idx < 2304) && ((b3 == 1) || (b3 == 0 && hasPrev) || (b3 == 2 && hasNext));
            kv[i] = (u32x4){0u, 0u, 0u, 0u};
            if (valid) kv[i] = *(const u32x4*)(ZA + (size_t)(row0 - 128 + kb) * 768 + 512 + g * 64 + part * 8);
        }
#pragma unroll
        for (int i = 0; i < 6; ++i) {
            const int idx = tid + 512 * i, d = idx / 48, part = idx % 48, kb0 = part * 8, b3 = kb0 >> 7;
            const bool valid = (b3 == 1) || (b3 == 0 && hasPrev) || (b3 == 2 && hasNext);
            vv[i] = (u32x4){0u, 0u, 0u, 0u};
            if (valid) vv[i] = *(const u32x4*)(ZT + (size_t)(1536 + g * 64 + d) * MTOT + row0 - 128 + kb0);
        }
        const int rkb = tid, rb3 = rkb >> 7;
        const bool rvalid = (rkb < 384) && ((rb3 == 1) || (rb3 == 0 && hasPrev) || (rb3 == 2 && hasNext));
        if (rvalid) {
            const bf16_t* src = ZA + (size_t)(row0 - 128 + rkb) * 768 + 512 + g * 64;
            k0 = *(const u32x4*)src; k1 = *(const u32x4*)(src + 8);
            const f32x4* tp = (const f32x4*)(rope + (size_t)(pos0 - 128 + rkb) * 8);
#pragma unroll
            for (int q = 0; q < 4; ++q) cs[q] = tp[q];
        }
#pragma unroll
        for (int i = 0; i < 5; ++i) { const int idx = tid + 512 * i, kb = idx / 6, part = 2 + idx % 6; if (idx < 2304) *(u32x4*)(Ks + kb * 144 + part * 16) = kv[i]; }
#pragma unroll
        for (int i = 0; i < 6; ++i) { const int idx = tid + 512 * i, d = idx / 48, part = idx % 48; *(u32x4*)(Vs + d * 784 + part * 16) = vv[i]; }
        if (rkb < 384) {
            const u32x4 r0 = rope_apply(k0, k1, cs, 0), r1 = rope_apply(k1, k0, cs, 1);
            *(u32x4*)(Ks + rkb * 144) = r0; *(u32x4*)(Ks + rkb * 144 + 16) = r1;
        }
    }
    __syncthreads();
    const int hh = w >> 1, head = g * 4 + hh;
    const float sinkv = PIN[14][l * 8 + head];
    const int r = lane & 31, h = lane >> 5;
    for (int qt = 0; qt < 2; ++qt) {
        const int qi = (w & 1) * 2 + qt;
        const int qrow = row0 + 32 * qi + r, qpos = pos0 + 32 * qi + r;
        const bf16_t* qsrc = ZA + (size_t)qrow * 768 + head * 64;
        bf16x8 qf[4];
        {
            u32x4 qv[4]; f32x4 cs[4];
#pragma unroll
            for (int s = 0; s < 4; ++s) qv[s] = *(const u32x4*)(qsrc + 16 * s + 8 * h);
            const u32x4 qo = *(const u32x4*)(qsrc + 8 * (1 - h));
            const f32x4* tp = (const f32x4*)(rope + (size_t)qpos * 8);
#pragma unroll
            for (int q = 0; q < 4; ++q) cs[q] = tp[q];
            qv[0] = rope_apply(qv[0], qo, cs, h);
#pragma unroll
            for (int s = 0; s < 4; ++s) {
#pragma unroll
                for (int q = 0; q < 4; ++q) qv[s][q] = pk2(bf_lo(qv[s][q]) * 0.125f, bf_hi(qv[s][q]) * 0.125f);
                qf[s] = __builtin_bit_cast(bf16x8, qv[s]);
            }
        }
        float mrun = sinkv, lsum = 1.0f;
        f32x16 O[2];
#pragma unroll
        for (int dt = 0; dt < 2; ++dt)
#pragma unroll
            for (int e = 0; e < 16; ++e) O[dt][e] = 0.f;
#pragma nounroll
        for (int ch = 0; ch < 3; ++ch) {
            f32x16 S[3];
#pragma unroll
            for (int c = 0; c < 3; ++c) {
#pragma unroll
                for (int e = 0; e < 16; ++e) S[c][e] = 0.f;
                const unsigned char* kp = Ks + (32 * (qi + 3 * ch + c) + r) * 144 + h * 16;
#pragma unroll
                for (int s = 0; s < 4; ++s) { const bf16x8 kf = *(const bf16x8*)(kp + s * 32); S[c] = __builtin_amdgcn_mfma_f32_32x32x16_bf16(kf, qf[s], S[c], 0, 0, 0); }
            }
            float cmax = -1e30f;
#pragma unroll
            for (int c = 0; c < 3; ++c) {
                const int tp = 3 * ch + c, b3 = (qi + tp) >> 2;
                const bool tv = (b3 == 1) || (b3 == 0 && hasPrev) || (b3 == 2 && hasNext);
#pragma unroll
                for (int e = 0; e < 16; ++e) {
                    const int kk = (e & 3) + 8 * (e >> 2) + 4 * h;
                    bool ok = tv;
                    if (c == 0) ok = ok && (tp != 0 || kk >= r);
                    if (c == 2) ok = ok && (tp != 8 || kk <= r);
                    const float sv = ok ? S[c][e] : -1e30f;
                    S[c][e] = sv; cmax = fmaxf(cmax, sv);
                }
            }
            cmax = fmaxf(cmax, __shfl_xor(cmax, 32));
            const float mnew = fmaxf(mrun, cmax), scl = __expf(mrun - mnew);
            mrun = mnew;
            float psum = 0.f;
#pragma unroll
            for (int c = 0; c < 3; ++c)
#pragma unroll
                for (int e = 0; e < 16; ++e) { const float pv = __expf(S[c][e] - mnew); S[c][e] = pv; psum += pv; }
            psum += __shfl_xor(psum, 32);
            lsum = lsum * scl + psum;
#pragma unroll
            for (int dt = 0; dt < 2; ++dt)
#pragma unroll
                for (int e = 0; e < 16; ++e) O[dt][e] *= scl;
#pragma unroll
            for (int c = 0; c < 3; ++c)
#pragma unroll
                for (int s2 = 0; s2 < 2; ++s2) {
                    u32x4 pp; pp[0] = pk2(S[c][8 * s2 + 0], S[c][8 * s2 + 1]); pp[1] = pk2(S[c][8 * s2 + 2], S[c][8 * s2 + 3]); pp[2] = pk2(S[c][8 * s2 + 4], S[c][8 * s2 + 5]); pp[3] = pk2(S[c][8 * s2 + 6], S[c][8 * s2 + 7]);
                    const bf16x8 pf = __builtin_bit_cast(bf16x8, pp);
#pragma unroll
                    for (int dt = 0; dt < 2; ++dt) {
                        const unsigned char* vp = Vs + (32 * dt + r) * 784 + (32 * (qi + 3 * ch + c) + 16 * s2 + 4 * h) * 2;
                        const u32x2 lo = *(const u32x2*)vp, hi = *(const u32x2*)(vp + 16);
                        u32x4 vv; vv[0] = lo[0]; vv[1] = lo[1]; vv[2] = hi[0]; vv[3] = hi[1];
                        O[dt] = __builtin_amdgcn_mfma_f32_32x32x16_bf16(__builtin_bit_cast(bf16x8, vv), pf, O[dt], 0, 0, 0);
                    }
                }
        }
        const float inv = 1.0f / lsum;
        bf16_t* op = A2 + (size_t)qrow * 1024 + head * 64;
#pragma unroll
        for (int dt = 0; dt < 2; ++dt)
#pragma unroll
            for (int gq = 0; gq < 4; ++gq) {
                u32x2 o; o[0] = pk2(O[dt][4 * gq + 0] * inv, O[dt][4 * gq + 1] * inv); o[1] = pk2(O[dt][4 * gq + 2] * inv, O[dt][4 * gq + 3] * inv);
                *(u32x2*)(op + 32 * dt + 8 * gq + 4 * h) = o;
            }
    }
    __syncthreads();
}

template <int LOGN>
__device__ __forceinline__ void hyena_unit(const Params& p, int l, int hu, unsigned char* smem, bool dry = false) {
    const int zl = launder0(); unsigned char* const wsp = lptr(p.ws);
    const int tid = ltid();
    constexpr int L = 1 << (LOGN - 1), logN = LOGN, N = 2 * L;
    const int bidx = (LOGN == 13 ? 0 : 16) + (hu >> 7), cq = hu & 127;
    const size_t rb = bidx < 16 ? (size_t)bidx * 4096 : 65536 + (size_t)(bidx - 16) * 2048;
    float2* buf = (float2*)smem;
    bf16_t* ZT = (bf16_t*)(wsp + OFF_ZT);
    const float* cw = PIN[16] + (size_t)l * 3 * 1536; const float* cb = PIN[17] + (size_t)l * 1536;
    const int t8 = tid * 8; const bool act = t8 < L;
    float u[2][2][8], x0c[2][2][8];
    if (act) {
        u32x4 raw[2][2][3]; bf16_t pvr[2][2][3], nxr[2][2][3];
        const int po = t8 > 0 ? -1 : 0, no = (t8 + 8 < L) ? 8 : 7;
#pragma unroll
        for (int pp = 0; pp < 2; ++pp)
#pragma unroll
            for (int cc = 0; cc < 2; ++cc)
#pragma unroll
                for (int gi = 0; gi < 3; ++gi) {
                    const bf16_t* src = ZT + (size_t)(gi * 512 + 4 * cq + 2 * pp + cc) * MTOT + rb + t8;
                    raw[pp][cc][gi] = *(const u32x4*)src; pvr[pp][cc][gi] = src[po]; nxr[pp][cc][gi] = src[no];
                }
#pragma unroll
        for (int pp = 0; pp < 2; ++pp) {
            const int c1 = 4 * cq + 2 * pp;
#pragma unroll
            for (int cc = 0; cc < 2; ++cc) {
                float cv[3][8];
#pragma unroll
                for (int gi = 0; gi < 3; ++gi) {
                    const int col = gi * 512 + c1 + cc;
                    float in[10];
                    in[0] = t8 > 0 ? bf2f(pvr[pp][cc][gi]) : 0.f;
                    in[9] = (t8 + 8 < L) ? bf2f(nxr[pp][cc][gi]) : 0.f;
#pragma unroll
                    for (int q = 0; q < 4; ++q) { in[1 + 2 * q] = bf_lo(raw[pp][cc][gi][q]); in[2 + 2 * q] = bf_hi(raw[pp][cc][gi][q]); }
                    const float w0 = cw[col], w1 = cw[1536 + col], w2 = cw[3072 + col], bsv = cb[col];
#pragma unroll
                    for (int j = 0; j < 8; ++j) cv[gi][j] = w0 * in[j] + w1 * in[j + 1] + w2 * in[j + 2] + bsv;
                }
#pragma unroll
                for (int j = 0; j < 8; ++j) { u[pp][cc][j] = cv[2][j] * cv[1][j]; x0c[pp][cc][j] = cv[0][j]; }
            }
            float2* bb = buf + pp * FFT_BUF_STRIDE;
#pragma unroll
            for (int j = 0; j < 8; ++j) { bb[PIX(t8 + j)] = make_float2(u[pp][0][j], u[pp][1][j]); bb[PIX(L + t8 + j)] = make_float2(0.f, 0.f); }
        }
    }
    constexpr int NI = L / 512 + 1;
    const float2* KFb = (const float2*)(wsp + OFF_KF) + (size_t)l * KF_LAYER + (bidx < 16 ? (size_t)(4 * cq) * KS4 : (size_t)512 * KS4 + (size_t)(4 * cq) * KS2);
    constexpr int KSTR = (LOGN == 13) ? KS4 : KS2;
    float bias4[2][2];
#pragma unroll
    for (int pp = 0; pp < 2; ++pp)
#pragma unroll
        for (int cc = 0; cc < 2; ++cc) bias4[pp][cc] = PIN[27][l * 512 + 4 * cq + 2 * pp + cc];
    float2 ka0[NI], kb0[NI], ka1[NI], kb1[NI];
    __syncthreads();
    fft_fwd<LOGN, 2>(buf, tid);
#pragma unroll
    for (int i = 0; i < NI; ++i) { const int k = min(tid + 512 * i, L); ka0[i] = KFb[k]; kb0[i] = KFb[KSTR + k]; }
#pragma unroll
    for (int i = 0; i < NI; ++i) { const int k = min(tid + 512 * i, L); ka1[i] = KFb[2 * KSTR + k]; kb1[i] = KFb[3 * KSTR + k]; }
    {
#pragma unroll
        for (int pp = 0; pp < 2; ++pp) {
            float2* bb = buf + pp * FFT_BUF_STRIDE;
#pragma unroll
            for (int i = 0; i < NI; ++i) {
                const int k = tid + 512 * i; if (k > L) continue;
                const int pa = (int)(__brev((unsigned)k) >> (32 - logN)), pb = (int)(__brev((unsigned)((N - k) & (N - 1))) >> (32 - logN));
                const float2 a = bb[PIX(pa)], b = bb[PIX(pb)];
                const float u1x = a.x + b.x, u1y = a.y - b.y, u2x = a.y + b.y, u2y = b.x - a.x;
                const float2 k1 = pp ? ka1[i] : ka0[i], k2 = pp ? kb1[i] : kb0[i];
                const float p1x = u1x * k1.x - u1y * k1.y, p1y = u1x * k1.y + u1y * k1.x;
                const float p2x = u2x * k2.x - u2y * k2.y, p2y = u2x * k2.y + u2y * k2.x;
                bb[PIX(pa)] = make_float2(p1x - p2y, p1y + p2x);
                if (pb != pa) bb[PIX(pb)] = make_float2(p1x + p2y, p2x - p1y);
            }
        }
    }
    __syncthreads();
    fft_inv<LOGN, 2>(buf, tid);
    if (act) {
#pragma unroll
        for (int pp = 0; pp < 2; ++pp) {
            const int c1 = 4 * cq + 2 * pp;
            const float2* bb = buf + pp * FFT_BUF_STRIDE;
#pragma unroll
            for (int cc = 0; cc < 2; ++cc) {
                const float bias = bias4[pp][cc];
                float o[8];
#pragma unroll
                for (int j = 0; j < 8; ++j) { const float2 y = bb[PIX(t8 + j)]; o[j] = ((cc ? y.y : y.x) + u[pp][cc][j] * bias) * x0c[pp][cc][j]; }
                u32x4 pk; pk[0] = pk2(o[0], o[1]); pk[1] = pk2(o[2], o[3]); pk[2] = pk2(o[4], o[5]); pk[3] = pk2(o[6], o[7]);
                if (!dry) *(u32x4*)(ZT + (size_t)(c1 + cc) * MTOT + rb + t8) = pk;
            }
        }
    }
    __syncthreads();
}

__device__ __forceinline__ void rms_unit(const Params& p, int l, int rc, unsigned char* smem) {
    const int zl = launder0(); unsigned char* const wsp = lptr(p.ws); float* const xp = lptr(p.X); (void)xp;
    const int tid = ltid(), lane = tid & 63, w = tid >> 6;
    const int row0 = rc * 64;
    bf16_t* A2 = (bf16_t*)(wsp + OFF_H);
    const bf16_t* ZT = (const bf16_t*)(wsp + OFF_ZT);
    const float* gn = PIN[15] + (size_t)l * 1024;
    {
        const f32x4 g0 = *(const f32x4*)(gn + lane * 8), g1 = *(const f32x4*)(gn + lane * 8 + 4);
        bf16_t* ap = A2 + (size_t)(row0 + w * 8) * 1024 + lane * 8;
        u32x4 va[8]; float ss[8];
#pragma unroll
        for (int rr = 0; rr < 8; ++rr) va[rr] = *(const u32x4*)(ap + (size_t)rr * 1024);
#pragma unroll
        for (int rr = 0; rr < 8; ++rr) {
            float a = 0.f;
#pragma unroll
            for (int q = 0; q < 4; ++q) { const float lo = bf_lo(va[rr][q]), hi = bf_hi(va[rr][q]); a += lo * lo + hi * hi; }
            ss[rr] = a;
        }
#pragma unroll
        for (int o = 1; o < 64; o <<= 1)
#pragma unroll
            for (int rr = 0; rr < 8; ++rr) ss[rr] += __shfl_xor(ss[rr], o);
#pragma unroll
        for (int rr = 0; rr < 8; ++rr) {
            const float rstd = rsqrtf(ss[rr] * (1.0f / 512.0f) + 1e-6f);
            u32x4 pk;
            pk[0] = pk2(bf_lo(va[rr][0]) * rstd * g0[0], bf_hi(va[rr][0]) * rstd * g0[1]); pk[1] = pk2(bf_lo(va[rr][1]) * rstd * g0[2], bf_hi(va[rr][1]) * rstd * g0[3]);
            pk[2] = pk2(bf_lo(va[rr][2]) * rstd * g1[0], bf_hi(va[rr][2]) * rstd * g1[1]); pk[3] = pk2(bf_lo(va[rr][3]) * rstd * g1[2], bf_hi(va[rr][3]) * rstd * g1[3]);
            *(u32x4*)(ap + (size_t)rr * 1024) = pk;
        }
    }
    bf16_t* T = (bf16_t*)smem;
    {
        const int c = tid;
        u32x4 vv[8];
#pragma unroll
        for (int q = 0; q < 8; ++q) vv[q] = *(const u32x4*)(ZT + (size_t)c * MTOT + row0 + q * 8);
#pragma unroll
        for (int q = 0; q < 8; ++q)
#pragma unroll
            for (int e = 0; e < 4; ++e) { T[(q * 8 + 2 * e) * 520 + c] = (bf16_t)(vv[q][e] & 0xffffu); T[(q * 8 + 2 * e + 1) * 520 + c] = (bf16_t)(vv[q][e] >> 16); }
    }
    __syncthreads();
    {
        const f32x4 g0 = *(const f32x4*)(gn + 512 + lane * 8), g1 = *(const f32x4*)(gn + 512 + lane * 8 + 4);
        u32x4 va[8]; float ss[8];
#pragma unroll
        for (int rr = 0; rr < 8; ++rr) va[rr] = *(const u32x4*)(T + (w * 8 + rr) * 520 + lane * 8);
#pragma unroll
        for (int rr = 0; rr < 8; ++rr) {
            float a = 0.f;
#pragma unroll
            for (int q = 0; q < 4; ++q) { const float lo = bf_lo(va[rr][q]), hi = bf_hi(va[rr][q]); a += lo * lo + hi * hi; }
            ss[rr] = a;
        }
#pragma unroll
        for (int o = 1; o < 64; o <<= 1)
#pragma unroll
            for (int rr = 0; rr < 8; ++rr) ss[rr] += __shfl_xor(ss[rr], o);
#pragma unroll
        for (int rr = 0; rr < 8; ++rr) {
            const float rstd = rsqrtf(ss[rr] * (1.0f / 512.0f) + 1e-6f);
            u32x4 pk;
            pk[0] = pk2(bf_lo(va[rr][0]) * rstd * g0[0], bf_hi(va[rr][0]) * rstd * g0[1]); pk[1] = pk2(bf_lo(va[rr][1]) * rstd * g0[2], bf_hi(va[rr][1]) * rstd * g0[3]);
            pk[2] = pk2(bf_lo(va[rr][2]) * rstd * g1[0], bf_hi(va[rr][2]) * rstd * g1[1]); pk[3] = pk2(bf_lo(va[rr][3]) * rstd * g1[2], bf_hi(va[rr][3]) * rstd * g1[3]);
            *(u32x4*)(A2 + (size_t)(row0 + w * 8 + rr) * 1024 + 512 + lane * 8) = pk;
        }
    }
    __syncthreads();
}

#define LAS __attribute__((address_space(3)))
#define XB_TMO      128
#define XB_XCNT(j)  (256  + 64 * (j))
#define XB_XSUB(j)  (1280 + 64 * (j))
#define XB_XGEN(j)  (2304 + 64 * (j))
#define XB_TOP      3328
#define XB_TOPGEN   3392
#define XCD_BAR_WORDS 3456
#define XB_SPIN_CAP (1u << 18)

__device__ __forceinline__ unsigned xb_ld(unsigned* p)              { return __hip_atomic_load(p, __ATOMIC_RELAXED, __HIP_MEMORY_SCOPE_AGENT); }
__device__ __forceinline__ unsigned xb_add(unsigned* p, unsigned v) { return __hip_atomic_fetch_add(p, v, __ATOMIC_RELAXED, __HIP_MEMORY_SCOPE_AGENT); }
__device__ __forceinline__ unsigned xb_xcc_id() { return (unsigned)__builtin_amdgcn_s_getreg((3 << 11) | 20) & 0xFu; }
#define XB_SPIN(cond, bar) do { unsigned _sp = 0; while (cond) { __builtin_amdgcn_s_sleep(1); \
    if ((++_sp & 255u) == 0u) { if (xb_ld(&(bar)[XB_TMO])) break; if (_sp > XB_SPIN_CAP) { atomicAdd(&(bar)[XB_TMO], 1u); break; } } } } while (0)

struct XcdBarrier {
    unsigned* bar; unsigned x;
    volatile LAS unsigned* st;
};

__device__ __forceinline__ XcdBarrier xcd_barrier_post(unsigned* bar, volatile LAS unsigned* st) {
    XcdBarrier b; b.bar = bar; b.x = xb_xcc_id(); b.st = st;
    if (threadIdx.x == 0) (void)xb_add(&bar[XB_XCNT(b.x)], 1u);
    return b;
}
__device__ __forceinline__ void xcd_barrier_complete(unsigned* bar, unsigned x, unsigned& nloc, unsigned& nx) {
    const unsigned G = gridDim.x * gridDim.y * gridDim.z;
    unsigned sum, cnt, mine, sp = 0u;
    for (;;) {
        sum = 0u; cnt = 0u; mine = 0u;
#pragma unroll
        for (unsigned j = 0; j < 16; ++j) { const unsigned c = xb_ld(&bar[XB_XCNT(j)]); sum += c; cnt += (c > 0u) ? 1u : 0u; mine = (j == x) ? c : mine; }
        if (sum == G) break;
        __builtin_amdgcn_s_sleep(1);
        if ((++sp & 255u) == 0u) { if (xb_ld(&bar[XB_TMO])) break; if (sp > XB_SPIN_CAP) { atomicAdd(&bar[XB_TMO], 1u); break; } }
    }
    nloc = mine > 0u ? mine : 1u; nx = cnt > 0u ? cnt : 1u;
}

__device__ __forceinline__ void xcd_barrier(const XcdBarrier& b) {
    asm volatile("s_waitcnt vmcnt(0)" ::: "memory");
    __syncthreads();
    if (threadIdx.x == 0) {
        unsigned* bar = b.bar;
        __builtin_amdgcn_s_waitcnt(0);
        unsigned nloc = b.st[0], nx = b.st[1];
        if (nloc == 0u) { xcd_barrier_complete(bar, b.x, nloc, nx); b.st[0] = nloc; b.st[1] = nx; }
        const unsigned old = xb_add(&bar[XB_XSUB(b.x)], 1u);
        const unsigned gen = old / nloc;
        if (old + 1u == (gen + 1u) * nloc) {
            __builtin_amdgcn_fence(__ATOMIC_RELEASE, "agent");
            asm volatile("s_waitcnt vmcnt(0)" ::: "memory");
            const unsigned og = xb_add(&bar[XB_TOP], 1u);
            const unsigned tg = og / nx;
            if (og + 1u == (tg + 1u) * nx) xb_add(&bar[XB_TOPGEN], 1u);
            else XB_SPIN(xb_ld(&bar[XB_TOPGEN]) == tg, bar);
            __builtin_amdgcn_fence(__ATOMIC_ACQUIRE, "agent");
            xb_add(&bar[XB_XGEN(b.x)], 1u);
            asm volatile("s_waitcnt vmcnt(0)" ::: "memory");
        } else {
            XB_SPIN(xb_ld(&bar[XB_XGEN(b.x)]) == gen, bar);
            __builtin_amdgcn_fence(__ATOMIC_ACQUIRE, "agent");
            asm volatile("s_waitcnt vmcnt(0)" ::: "memory");
        }
    }
    __syncthreads();
}

__global__ void __launch_bounds__(512) hymba_fwd(Params p) {
    extern __shared__ __attribute__((aligned(16))) unsigned char smem[];
    cg::grid_group grid = cg::this_grid();
    volatile LAS unsigned* bst = (volatile LAS unsigned*)(smem + 135168 + 512);
    if (threadIdx.x < 2) bst[threadIdx.x] = 0u;
    __syncthreads();
    XcdBarrier xbar = xcd_barrier_post((unsigned*)(p.ws + OFF_BAR), bst);
    PG8_LAS unsigned char* lds = (PG8_LAS unsigned char*)smem;
    const int G = gridDim.x, wg = blockIdx.x;
    for (int ph = p.ph_lo; ph < p.ph_hi; ++ph) {
        const int zl = launder0(); unsigned char* const wsp = lptr(p.ws); float* const xp = lptr(p.X);
        bf16_t* Hb = (bf16_t*)(wsp + OFF_H); bf16_t* ACT = (bf16_t*)(wsp + OFF_ACT); float* MOD = (float*)(wsp + OFF_MOD);
#ifdef PROBE_P0
        if (ph == 0) { phase0a(p, smem); __syncthreads(); }
        if (ph == 1) { phase0b(p, smem); __syncthreads(); }
#endif
        if (EN_P0 && ph == 0) phase0a(p, smem);
        else if (EN_P1 && ph == 1) phase0b(p, smem);
        else {
            const int l = (ph - 2) / 11, s = (ph - 2) % 11;
            const bf16_t* wl = (const bf16_t*)(wsp + OFF_W) + (size_t)l * WL_ELEMS;
            if (EN_GEMM && (s == 0 || s == 8 || s == 1 || s == 9 || s == 3 || s == 6)) {
                const int nsub = (s == 3) ? 2 : 1;
                for (int sub = 0; sub < nsub; ++sub) {
                    pg8::Gemm g; pg8::EpiAny E;
                    E.O = ACT; E.ldc = 2816; E.X = xp; E.gate = MOD; E.coef = 0.5f; E.mode = 0; E.perm = true;
                    E.stats = (const float2*)(wsp + OFF_STATS); E.lng = nullptr; E.lnb = nullptr;
                    if (s == 0 || s == 8) { g.A = Hb; g.Bt = wl + (s ? WO_WI2 : WO_WI1); g.M = MTOT; g.N = 5632; g.K = 1024; }
                    else if (s == 1 || s == 9) { g.A = ACT; g.Bt = wl + (s == 9 ? WO_WO2 : WO_WO1); g.M = MTOT; g.N = 1024; g.K = 2816;
                        E.mode = 1; E.perm = false; E.gate = MOD + (size_t)l * 32 * 9216 + (s == 9 ? 8 : 2) * 1024;
                        const int lnrow = (s == 9) ? l * 3 + 1 : l * 3 - 1;
                        if (lnrow >= 0) { E.lng = PIN[10] + (size_t)lnrow * 1024; E.lnb = PIN[11] + (size_t)lnrow * 1024; } }
                    else if (s == 6) { g.A = Hb; g.Bt = wl + WO_WOUT; g.M = MTOT; g.N = 1024; g.K = 1024;
                        E.mode = 1; E.perm = false; E.gate = MOD + (size_t)l * 32 * 9216 + 5 * 1024; E.coef = 1.0f;
                        E.lng = PIN[10] + (size_t)(l * 3) * 1024; E.lnb = PIN[11] + (size_t)(l * 3) * 1024; }
                    else if (sub == 0) { g.A = Hb; g.Bt = wl + WO_WINA; g.M = MTOT; g.N = 768; g.K = 1024; E.mode = 2; E.O = (bf16_t*)(wsp + OFF_ZA); E.ldc = 768; }
                    else { g.A = wl + WO_WINB; g.Bt = Hb; g.M = 1792; g.N = MTOT; g.K = 1024; E.mode = 2; E.O = (bf16_t*)(wsp + OFF_ZT); E.ldc = (size_t)MTOT; }
                    pg8::StaticOrder S; S.init(g.M, g.N, G, (s == 3 && sub == 1) ? G - 1 - wg : wg);
                    pg8::gemm_phase<pg8::EpiAny, pg8::StaticOrder, GEMM_ALIGN, GEMM_SP2>(lds, g, S, E);
                }
            } else if (EN_LN && (s == 2 || s == 7 || s == 10)) {
                const int li = s == 2 ? 0 : (s == 7 ? 1 : 2);
                const float* md = nullptr;
                if (s == 2) md = MOD + (size_t)l * 32 * 9216 + 3 * 1024;
                else if (s == 7) md = MOD + (size_t)l * 32 * 9216 + 6 * 1024;
                else if (l + 1 < NLAYER) md = MOD + (size_t)(l + 1) * 32 * 9216;
#ifdef PROBE_LN
                if (md) lnmod_phase(wsp, xp, PIN[10] + (size_t)(l * 3 + li) * 1024, PIN[11] + (size_t)(l * 3 + li) * 1024, md, md == nullptr);
#endif
                lnmod_phase(wsp, xp, PIN[10] + (size_t)(l * 3 + li) * 1024, PIN[11] + (size_t)(l * 3 + li) * 1024, md, md == nullptr);
            } else if (s == 4) {
#ifdef PROBE_ATT
                for (int ua = wg; ua < 1536; ua += G) attn_unit(p, l, ua, smem);
#endif
#ifdef PROBE_HY
                { for (int hu = wg; hu < 2048; hu += G) hyena_unit<13>(p, l, hu, smem, launder0() == 0); for (int hu = wg; hu < 2048; hu += G) hyena_unit<12>(p, l, hu, smem, launder0() == 0); }
#endif
                if (EN_ATT) for (int ua = wg; ua < 1536; ua += G) attn_unit(p, l, ua, smem);
                if (EN_HY) { for (int hu = wg; hu < 2048; hu += G) hyena_unit<13>(p, l, hu, smem); for (int hu = wg; hu < 2048; hu += G) hyena_unit<12>(p, l, hu, smem); }
            } else if (EN_RMS && s == 5) {
                for (int rc = wg; rc < 1536; rc += G) rms_unit(p, l, rc, smem);
            }
        }
#ifdef PROBE_SYNC
        if (ph + 1 < p.ph_hi) { grid.sync(); grid.sync(); grid.sync(); }
#endif
        if (ph + 1 < p.ph_hi) { if (ph == 0) grid.sync(); else xcd_barrier(xbar); }
    }
}

extern "C" void kernel_launch(void* const* d_in, const int* in_sizes, int n_in, void* d_out, int out_size, void* d_ws, size_t ws_size, hipStream_t stream) {
    static int grid = 0;
    if (grid == 0) {
        if (n_in != 28 || ws_size < WS_NEED) { fprintf(stderr, "kernel_launch: unexpected n_in %d or ws_size %zu (need %zu)\n", n_in, ws_size, (size_t)WS_NEED); grid = -1; return; }
        int dev = 0, cus = 0, per_cu = 0;
        (void)hipGetDevice(&dev);
        (void)hipDeviceGetAttribute(&cus, hipDeviceAttributeMultiprocessorCount, dev);
        if (hipFuncSetAttribute((const void*)hymba_fwd, hipFuncAttributeMaxDynamicSharedMemorySize, LDS_BYTES) != hipSuccess) { fprintf(stderr, "kernel_launch: hipFuncSetAttribute failed\n"); grid = -1; return; }
        if (hipOccupancyMaxActiveBlocksPerMultiprocessor(&per_cu, (const void*)hymba_fwd, 512, LDS_BYTES) != hipSuccess || per_cu < 1) { fprintf(stderr, "kernel_launch: occupancy query gave %d\n", per_cu); per_cu = 1; }
        (void)hipGetLastError();
        grid = cus * 1;
        if (grid <= 0) grid = 256;
    }
    if (grid < 0) return;
    Params p{};
    for (int i = 0; i < 28; ++i) p.in[i] = (const float*)d_in[i];
    p.X = (float*)d_out; p.ws = (unsigned char*)d_ws; p.ph_lo = 0; p.ph_hi = NPHASE;
    if (hipMemsetAsync((unsigned char*)d_ws + OFF_BAR, 0, BAR_BYTES, stream) != hipSuccess) { fprintf(stderr, "kernel_launch: memset of the barrier words failed\n"); return; }
    void* args[] = {&p};
    hipError_t e = hipLaunchCooperativeKernel((const void*)hymba_fwd, dim3(grid), dim3(512), args, LDS_BYTES, stream);
    if (e != hipSuccess) fprintf(stderr, "kernel_launch: cooperative launch failed: %s (grid %d)\n", hipGetErrorString(e), grid);
}
```
